# Optimizing an MI355X kernel written in HIP

```python
import math
import jax, jax.numpy as jnp
from jax import lax
import numpy as np

D_MODEL = 2048
BATCH = 8
SEQ = 4096
DEPTH = 1
DEC_BATCH = 16
DEC_SEQ = 2048
PAST_LEN = 128

N_HEADS_A = 8
HEAD_DIM_A = 128
WIDTH_A = N_HEADS_A * HEAD_DIM_A
DILATED_CONFIGS = ((128, 1), (512, 4), (2048, 16))
N_HEADS_B = 8
DIFF_QK_DIM = 64
DIFF_V_DIM = 2 * DIFF_QK_DIM
WIDTH_B = N_HEADS_B * DIFF_V_DIM
Q_BLOCK = 128
MIX_WIDTH = WIDTH_A + WIDTH_B
PROJ_WIDTH = 3 * WIDTH_A + 3 * WIDTH_B
D_FF = ((8 * D_MODEL // 3 + 255) // 256) * 256
N_BUCKETS = 32
MAX_DISTANCE = 1024
N_BIAS_HEADS = N_HEADS_A + N_HEADS_B
EPS = 1e-6
NEG_INF = -1e30

kernel_name = "hymba_dilated_diff_encoder"


def rms_norm(x, g):
    xf = x.astype(jnp.float32)
    y = xf * lax.rsqrt(jnp.mean(xf * xf, axis=-1, keepdims=True) + EPS)
    return (y * g.astype(jnp.float32)).astype(x.dtype)


def rel_bucket(rel):
    half = N_BUCKETS // 2
    max_exact = half // 2
    n = jnp.abs(rel)
    nf = jnp.maximum(n, 1).astype(jnp.float32)
    large = max_exact + (jnp.log(nf / max_exact) / math.log(MAX_DISTANCE / max_exact)
                         * (half - max_exact)).astype(jnp.int32)
    large = jnp.minimum(large, half - 1)
    return jnp.where(rel > 0, half, 0) + jnp.where(n < max_exact, n, large)


def dilated_branch(q, k, v, rel_bias, window, dilation):
    B, S, H, Dh = q.shape
    half = window // (2 * dilation)
    blk = half
    L = S // dilation
    nb = -(-L // blk)
    Lp = nb * blk

    def to_phases(t):
        return t.reshape(B, L, dilation, H, Dh).transpose(0, 2, 1, 3, 4).reshape(B * dilation, L, H, Dh)

    qs = jnp.pad(to_phases(q), ((0, 0), (0, Lp - L), (0, 0), (0, 0))).reshape(B * dilation, nb, blk, H, Dh)
    pad_kv = ((0, 0), (blk, Lp - L + blk), (0, 0), (0, 0))

    def windows(t):
        tb = jnp.pad(to_phases(t), pad_kv).reshape(B * dilation, nb + 2, blk, H, Dh)
        return jnp.concatenate([tb[:, :-2], tb[:, 1:-1], tb[:, 2:]], axis=2)

    kw = windows(k)
    vw = windows(v).astype(jnp.float32)
    kpos = jnp.arange(-blk, Lp + blk).reshape(nb + 2, blk)
    kpos_w = jnp.concatenate([kpos[:-2], kpos[1:-1], kpos[2:]], axis=1)
    kvalid = (kpos_w >= 0) & (kpos_w < L)
    rel = jnp.arange(3 * blk)[None, :] - blk - jnp.arange(blk)[:, None]
    mask = (jnp.abs(rel) <= half)[None] & kvalid[:, None, :]
    bias = rel_bias[rel_bucket(rel * dilation)][..., :N_HEADS_A].transpose(2, 0, 1)
    scale = 1.0 / math.sqrt(Dh)
    s = jnp.einsum('znqhd,znkhd->znhqk', qs, kw, preferred_element_type=jnp.float32) * scale
    s = s + bias.astype(jnp.float32)
    s = jnp.where(mask[None, :, None], s, NEG_INF)
    m = jnp.max(s, axis=-1, keepdims=True)
    p = jnp.exp(s - m)
    l = jnp.sum(p, axis=-1)
    o = jnp.einsum('znhqk,znkhd->znqhd', p, vw) / jnp.moveaxis(l, 2, 3)[..., None]
    m = jnp.moveaxis(m[..., 0], 2, 3)
    l = jnp.moveaxis(l, 2, 3)

    def from_phases(t):
        rest = t.shape[3:]
        t = t.reshape((B, dilation, Lp) + rest)[:, :, :L]
        t = jnp.swapaxes(t, 1, 2)
        return t.reshape((B, S) + rest)

    return from_phases(o), from_phases(m), from_phases(l)


def dilated_mixture(q, k, v, rel_bias):
    outs = [dilated_branch(q, k, v, rel_bias, w, d) for (w, d) in DILATED_CONFIGS]
    o_all = jnp.stack([o for o, _, _ in outs])
    m_all = jnp.stack([m for _, m, _ in outs])
    l_all = jnp.stack([l for _, _, l in outs])
    wts = l_all * jnp.exp(m_all - jnp.max(m_all, axis=0, keepdims=True))
    return jnp.sum(wts[..., None] * o_all, axis=0) / jnp.sum(wts, axis=0)[..., None]


def diff_attention(q, k, v, lam, rel_bias):
    B, S, H = q.shape[:3]
    nq = S // Q_BLOCK
    qb = q.reshape(B, nq, Q_BLOCK, H, 2, DIFF_QK_DIM).transpose(1, 0, 2, 3, 4, 5)
    starts = jnp.arange(nq) * Q_BLOCK
    kpos = jnp.arange(S)
    vf = v.astype(jnp.float32)
    scale = 1.0 / math.sqrt(DIFF_QK_DIM)

    def block(args):
        qblk, q0 = args
        s = jnp.einsum('bqhcd,bkhcd->bhcqk', qblk, k, preferred_element_type=jnp.float32) * scale
        rel = kpos[None, :] - (q0 + jnp.arange(Q_BLOCK))[:, None]
        bias = rel_bias[rel_bucket(rel)][..., N_HEADS_A:].transpose(2, 0, 1)
        p = jax.nn.softmax(s + bias.astype(jnp.float32)[None, :, None], axis=-1)
        a = p[:, :, 0] - lam * p[:, :, 1]
        return jnp.einsum('bhqk,bkhd->bqhd', a, vf)

    o = lax.map(block, (qb, starts))
    return o.transpose(1, 0, 2, 3, 4).reshape(B, S, H, DIFF_V_DIM)


def encoder_layer(x, layer, pre_mix_g, post_mix_g, pre_ffn_g, post_ffn_g, w_in, w_out, norm_a_g,
                  lambda_q1, lambda_k1, lambda_q2, lambda_k2, subln_g, w_gate, w_up, w_down, rel_bias):
    B, S, _ = x.shape
    h = rms_norm(x, pre_mix_g)
    proj = jnp.einsum('bsd,de->bse', h, w_in)
    qa, ka, va, qb, kb, vb = jnp.split(proj, 6, axis=-1)
    qa = qa.reshape(B, S, N_HEADS_A, HEAD_DIM_A)
    ka = ka.reshape(B, S, N_HEADS_A, HEAD_DIM_A)
    va = va.reshape(B, S, N_HEADS_A, HEAD_DIM_A)
    oa = dilated_mixture(qa, ka, va, rel_bias).reshape(B, S, WIDTH_A)
    oa = rms_norm(oa, norm_a_g)

    qb = qb.reshape(B, S, N_HEADS_B, 2, DIFF_QK_DIM)
    kb = kb.reshape(B, S, N_HEADS_B, 2, DIFF_QK_DIM)
    vb = vb.reshape(B, S, N_HEADS_B, DIFF_V_DIM)
    lambda_init = 0.8 - 0.6 * math.exp(-0.3 * layer)
    lam = (jnp.exp(jnp.sum(lambda_q1.astype(jnp.float32) * lambda_k1.astype(jnp.float32)))
           - jnp.exp(jnp.sum(lambda_q2.astype(jnp.float32) * lambda_k2.astype(jnp.float32)))
           + lambda_init)
    ob = diff_attention(qb, kb, vb, lam, rel_bias)
    ob = rms_norm(ob, subln_g) * (1.0 - lambda_init)
    ob = ob.reshape(B, S, WIDTH_B)

    mixed = jnp.concatenate([oa.astype(jnp.float32), ob], axis=-1).astype(x.dtype)
    y = jnp.einsum('bse,ed->bsd', mixed, w_out)
    x = x + rms_norm(y, post_mix_g)
    h = rms_norm(x, pre_ffn_g)
    f = jax.nn.silu(jnp.einsum('bsd,df->bsf', h, w_gate)) * jnp.einsum('bsd,df->bsf', h, w_up)
    f = jnp.einsum('bsf,fd->bsd', f, w_down)
    return x + rms_norm(f, post_ffn_g)


def trunk(x, pre_mix_g, post_mix_g, pre_ffn_g, post_ffn_g, w_in, w_out, norm_a_g,
          lambda_q1, lambda_k1, lambda_q2, lambda_k2, subln_g, w_gate, w_up, w_down, rel_bias):
    for layer in range(DEPTH):
        x = encoder_layer(x, layer, pre_mix_g[layer], post_mix_g[layer], pre_ffn_g[layer], post_ffn_g[layer],
                          w_in[layer], w_out[layer], norm_a_g[layer], lambda_q1[layer], lambda_k1[layer],
                          lambda_q2[layer], lambda_k2[layer], subln_g[layer], w_gate[layer], w_up[layer],
                          w_down[layer], rel_bias)
    return x


def setup_inputs(seed: int = 0) -> dict:
    key = jax.random.key(seed)
    ks = jax.random.split(key, 20)
    f32 = jnp.float32

    def gain(k, n):
        return 1.0 + 0.02 * jax.random.normal(k, (DEPTH, n), f32)

    return {
        "x_prompt": jax.random.normal(ks[0], (BATCH, SEQ, D_MODEL), f32),
        "x_sample": jax.random.normal(ks[1], (DEC_BATCH, DEC_SEQ, D_MODEL), f32),
        "pre_mix_g": gain(ks[2], D_MODEL),
        "post_mix_g": gain(ks[3], D_MODEL),
        "pre_ffn_g": gain(ks[4], D_MODEL),
        "post_ffn_g": gain(ks[5], D_MODEL),
        "w_in": jax.random.normal(ks[6], (DEPTH, D_MODEL, PROJ_WIDTH), f32) * D_MODEL ** -0.5,
        "w_out": jax.random.normal(ks[7], (DEPTH, MIX_WIDTH, D_MODEL), f32) * MIX_WIDTH ** -0.5,
        "norm_a_g": gain(ks[8], WIDTH_A),
        "lambda_q1": 0.1 * jax.random.normal(ks[9], (DEPTH, DIFF_QK_DIM), f32),
        "lambda_k1": 0.1 * jax.random.normal(ks[10], (DEPTH, DIFF_QK_DIM), f32),
        "lambda_q2": 0.1 * jax.random.normal(ks[11], (DEPTH, DIFF_QK_DIM), f32),
        "lambda_k2": 0.1 * jax.random.normal(ks[12], (DEPTH, DIFF_QK_DIM), f32),
        "subln_g": gain(ks[13], DIFF_V_DIM),
        "w_gate": jax.random.normal(ks[14], (DEPTH, D_MODEL, D_FF), f32) * D_MODEL ** -0.5,
        "w_up": jax.random.normal(ks[15], (DEPTH, D_MODEL, D_FF), f32) * D_MODEL ** -0.5,
        "w_down": jax.random.normal(ks[16], (DEPTH, D_FF, D_MODEL), f32) * D_FF ** -0.5,
        "rel_bias": 0.2 * jax.random.normal(ks[17], (N_BUCKETS, N_BIAS_HEADS), f32),
    }


def reference(x_prompt, x_sample, pre_mix_g, post_mix_g, pre_ffn_g, post_ffn_g, w_in, w_out, norm_a_g,
              lambda_q1, lambda_k1, lambda_q2, lambda_k2, subln_g, w_gate, w_up, w_down, rel_bias):
    y_prompt = trunk(x_prompt, pre_mix_g, post_mix_g, pre_ffn_g, post_ffn_g, w_in, w_out, norm_a_g,
                     lambda_q1, lambda_k1, lambda_q2, lambda_k2, subln_g, w_gate, w_up, w_down, rel_bias)
    y_sample = trunk(x_sample, pre_mix_g, post_mix_g, pre_ffn_g, post_ffn_g, w_in, w_out, norm_a_g,
                     lambda_q1, lambda_k1, lambda_q2, lambda_k2, subln_g, w_gate, w_up, w_down, rel_bias)
    return (y_prompt, y_sample)
```

```cpp
#include <hip/hip_runtime.h>
#include <hip/hip_cooperative_groups.h>
#include <cstdio>
#include <cstdint>
namespace cg = cooperative_groups;

namespace pg8 {
#define PG8_LAS __attribute__((address_space(3)))
typedef unsigned short bf16_t;
typedef short bf16x8 __attribute__((ext_vector_type(8)));
typedef float f32x4 __attribute__((ext_vector_type(4)));
typedef unsigned u32x4 __attribute__((ext_vector_type(4)));
constexpr int BM = 256, BK = 64, HALF = 128, HTB = HALF * BK * 2  , STAGE_BYTES = 8 * HTB, NXCD = 8, WGM = 8;

__host__ __device__ __forceinline__ int lds_byte(int r, int c) { const int st = (r >> 4) * 2 + (c >> 5), rr = r & 15, cc = c & 31, ob = rr * 64 + cc * 2; return st * 1024 + (ob ^ (((ob >> 9) & 1) << 5)); }
__host__ __device__ __forceinline__ void stage_rc(int b, int& R, int& C) { const int st = b / 1024, sb = b % 1024, swz = sb ^ (((sb >> 9) & 1) << 5); R = (st >> 1) * 16 + swz / 64; C = (st & 1) * 32 + (swz % 64) / 2; }
__host__ __device__ __forceinline__ int perm32(int rho) { const int n = rho >> 4, i = rho & 15; return 8 * (i >> 2) + 4 * n + (i & 3); }

struct Unit { int pm, pn; };
struct Gemm { const bf16_t* A; const bf16_t* Bt; int M, N, K; };

struct StaticOrder {
    int nM, nN, nwg, G, c;
    __host__ __device__ void init(int M, int N, int G_, int c_) { nM = M / BM; nN = N / BM; nwg = nM * nN; G = G_; c = c_; }
    __host__ __device__ bool next(int i, Unit& u) const {
        const long L = (long)i * G + c; if (L >= nwg) return false;
        int wgid = (int)L; { const int q = nwg / NXCD, r = nwg % NXCD, xcd = wgid % NXCD, off = wgid / NXCD; wgid = (xcd < r ? xcd * (q + 1) : r * (q + 1) + (xcd - r) * q) + off; }
        const int nig = WGM * nN, gid = wgid / nig, fm = gid * WGM, gsz = (nM - fm) < WGM ? (nM - fm) : WGM;
        u.pm = fm + ((wgid % nig) % gsz); u.pn = (wgid % nig) / gsz; return true;
    }
    __device__ __forceinline__ void a_ready(const Unit&) const {}
    __device__ __forceinline__ void done(const Unit&) const {}
};
__device__ __forceinline__ unsigned cvt_pk_bf16(float lo, float hi) { unsigned r; asm volatile("v_cvt_pk_bf16_f32 %0, %1, %2" : "=v"(r) : "v"(lo), "v"(hi)); return r; }
typedef float f32x2 __attribute__((ext_vector_type(2)));
struct EpiBf16S {
    static constexpr bool PERM = true, AFTER_DRAIN = false;
    bf16_t* O; int ldc; float sA, sB;
    __device__ __forceinline__ void operator()(const f32x4 (&acc)[2][2][4][2], const Unit& u, int wr, int wc, int fr, int fq) const {
        const int row0 = u.pm * BM + wr * 64 + fr, col0 = u.pn * BM + wc * 32 + 8 * fq;
        const float sc = (u.pn < 4) ? sA : ((u.pn >= 12 && u.pn < 16) ? sB : 1.f);
#pragma unroll
        for (int ai = 0; ai < 2; ++ai)
#pragma unroll
            for (int m = 0; m < 4; ++m) { bf16_t* rowp = O + (size_t)(row0 + ai * HALF + m * 16) * ldc + col0;
#pragma unroll
                for (int bj = 0; bj < 2; ++bj) { const f32x4 v0 = acc[ai][bj][m][0] * sc, v1 = acc[ai][bj][m][1] * sc;
                    u32x4 w; w.x = cvt_pk_bf16(v0[0], v0[1]); w.y = cvt_pk_bf16(v0[2], v0[3]); w.z = cvt_pk_bf16(v1[0], v1[1]); w.w = cvt_pk_bf16(v1[2], v1[3]);
                    *(u32x4*)(rowp + bj * HALF) = w; } }
    }
};
__device__ __forceinline__ float silu_mul(float g, float u) { return g * u * __builtin_amdgcn_rcpf(1.f + __builtin_amdgcn_exp2f(-1.4426950408889634f * g)); }
struct EpiSwiGLU {
    static constexpr bool PERM = true, AFTER_DRAIN = false;
    bf16_t* O; int ldc;
    __device__ __forceinline__ void operator()(const f32x4 (&acc)[2][2][4][2], const Unit& u, int wr, int wc, int fr, int fq) const {
        const int row0 = u.pm * BM + wr * 64 + fr, col0 = u.pn * HALF + wc * 32 + 8 * fq;
#pragma unroll
        for (int ai = 0; ai < 2; ++ai)
#pragma unroll
            for (int m = 0; m < 4; ++m) { bf16_t* rowp = O + (size_t)(row0 + ai * HALF + m * 16) * ldc + col0;
                const f32x4 g0 = acc[ai][0][m][0], g1 = acc[ai][0][m][1], u0 = acc[ai][1][m][0], u1 = acc[ai][1][m][1];
                u32x4 w; w.x = cvt_pk_bf16(silu_mul(g0[0], u0[0]), silu_mul(g0[1], u0[1])); w.y = cvt_pk_bf16(silu_mul(g0[2], u0[2]), silu_mul(g0[3], u0[3]));
                w.z = cvt_pk_bf16(silu_mul(g1[0], u1[0]), silu_mul(g1[1], u1[1])); w.w = cvt_pk_bf16(silu_mul(g1[2], u1[2]), silu_mul(g1[3], u1[3]));
                *(u32x4*)rowp = w; }
    }
};

struct PanelOrder {
    int c, nrounds;
    __device__ __forceinline__ bool next(int i, Unit& u) const { if (i >= nrounds) return false; const int x = c & 7, j = c >> 3; u.pm = 32 * i + 4 * x + (j >> 3); u.pn = j & 7; return true; }
    __device__ __forceinline__ void a_ready(const Unit&) const {}
    __device__ __forceinline__ void done(const Unit&) const {}
};
__device__ __forceinline__ void panel_sync(unsigned* cnt) {
    asm volatile("s_waitcnt vmcnt(0)" ::: "memory");
    __builtin_amdgcn_s_barrier();
    if (threadIdx.x == 0) {
        __builtin_amdgcn_fence(__ATOMIC_RELEASE, "agent");
        __hip_atomic_fetch_add(cnt, 1u, __ATOMIC_RELAXED, __HIP_MEMORY_SCOPE_AGENT);
        unsigned spins = 0;
        while (__hip_atomic_load(cnt, __ATOMIC_RELAXED, __HIP_MEMORY_SCOPE_AGENT) < 8u && ++spins < (1u << 24)) __builtin_amdgcn_s_sleep(1);
        __builtin_amdgcn_fence(__ATOMIC_ACQUIRE, "agent");
        asm volatile("s_waitcnt vmcnt(0)" ::: "memory");
    }
    __builtin_amdgcn_s_barrier();
}
__device__ __forceinline__ float ld_sc1(const float* p) { return __hip_atomic_load(p, __ATOMIC_RELAXED, __HIP_MEMORY_SCOPE_AGENT); }
__device__ __forceinline__ float quad_row_sum(float s) { s += __shfl_xor(s, 16); s += __shfl_xor(s, 32); return s; }
__device__ __forceinline__ float dot4(f32x4 v) { return (v[0] * v[0] + v[1] * v[1]) + (v[2] * v[2] + v[3] * v[3]); }
struct EpiNormResNorm {
    static constexpr bool PERM = true, AFTER_DRAIN = false;
    const float* xp; const float* xs; bf16_t* X1; bf16_t* Hn; const float* g1; const float* g2; float* ss1; float* ss2; unsigned* cnt1; unsigned* cnt2;
    __device__ __forceinline__ void operator()(f32x4 (&acc)[2][2][4][2], const Unit& u, int wr, int wc, int fr, int fq) const {
        const int row0 = u.pm * BM + wr * 64 + fr, col0 = u.pn * BM + wc * 32 + 8 * fq;
#pragma unroll
        for (int ai = 0; ai < 2; ++ai)
#pragma unroll
            for (int m = 0; m < 4; ++m) { float s = 0.f;
#pragma unroll
                for (int bj = 0; bj < 2; ++bj) s += dot4(acc[ai][bj][m][0]) + dot4(acc[ai][bj][m][1]);
                s = quad_row_sum(s);
                if (fq == 0) __hip_atomic_fetch_add(ss1 + row0 + ai * HALF + m * 16, s, __ATOMIC_RELAXED, __HIP_MEMORY_SCOPE_AGENT); }
        panel_sync(cnt1 + 64 * u.pm);
        f32x4 gv[2][2];
#pragma unroll
        for (int bj = 0; bj < 2; ++bj) { gv[bj][0] = *(const f32x4*)(g1 + col0 + bj * HALF); gv[bj][1] = *(const f32x4*)(g1 + col0 + bj * HALF + 4); }
#pragma unroll
        for (int ai = 0; ai < 2; ++ai)
#pragma unroll
            for (int m = 0; m < 4; ++m) { const int row = row0 + ai * HALF + m * 16;
                const float r1 = 1.f / sqrtf(ld_sc1(ss1 + row) * (1.f / 2048.f) + 1e-6f);
                const float* xrow = (row < 32768 ? xp + (size_t)row * 2048 : xs + (size_t)(row - 32768) * 2048) + col0;
                bf16_t* orow = X1 + (size_t)row * 2048 + col0; float s = 0.f;
#pragma unroll
                for (int bj = 0; bj < 2; ++bj) { const f32x4 x0 = *(const f32x4*)(xrow + bj * HALF), x1 = *(const f32x4*)(xrow + bj * HALF + 4);
                    const f32x4 v0 = x0 + acc[ai][bj][m][0] * r1 * gv[bj][0], v1 = x1 + acc[ai][bj][m][1] * r1 * gv[bj][1];
                    acc[ai][bj][m][0] = v0; acc[ai][bj][m][1] = v1; s += dot4(v0) + dot4(v1);
                    u32x4 w; w.x = cvt_pk_bf16(v0[0], v0[1]); w.y = cvt_pk_bf16(v0[2], v0[3]); w.z = cvt_pk_bf16(v1[0], v1[1]); w.w = cvt_pk_bf16(v1[2], v1[3]); *(u32x4*)(orow + bj * HALF) = w; }
                s = quad_row_sum(s);
                if (fq == 0) __hip_atomic_fetch_add(ss2 + row, s, __ATOMIC_RELAXED, __HIP_MEMORY_SCOPE_AGENT); }
        panel_sync(cnt2 + 64 * u.pm);
#pragma unroll
        for (int bj = 0; bj < 2; ++bj) { gv[bj][0] = *(const f32x4*)(g2 + col0 + bj * HALF); gv[bj][1] = *(const f32x4*)(g2 + col0 + bj * HALF + 4); }
#pragma unroll
        for (int ai = 0; ai < 2; ++ai)
#pragma unroll
            for (int m = 0; m < 4; ++m) { const int row = row0 + ai * HALF + m * 16;
                const float r2 = 1.f / sqrtf(ld_sc1(ss2 + row) * (1.f / 2048.f) + 1e-6f);
                bf16_t* hrow = Hn + (size_t)row * 2048 + col0;
#pragma unroll
                for (int bj = 0; bj < 2; ++bj) { const f32x4 v0 = acc[ai][bj][m][0] * r2 * gv[bj][0], v1 = acc[ai][bj][m][1] * r2 * gv[bj][1];
                    u32x4 w; w.x = cvt_pk_bf16(v0[0], v0[1]); w.y = cvt_pk_bf16(v0[2], v0[3]); w.z = cvt_pk_bf16(v1[0], v1[1]); w.w = cvt_pk_bf16(v1[2], v1[3]);
                    *(u32x4*)(hrow + bj * HALF) = w; } }
    }
};
struct EpiNormResOut {
    static constexpr bool PERM = true, AFTER_DRAIN = false;
    float* OUT; const bf16_t* X1; const float* g; float* ss; unsigned* cnt;
    __device__ __forceinline__ void operator()(f32x4 (&acc)[2][2][4][2], const Unit& u, int wr, int wc, int fr, int fq) const {
        const int row0 = u.pm * BM + wr * 64 + fr, col0 = u.pn * BM + wc * 32 + 8 * fq;
#pragma unroll
        for (int ai = 0; ai < 2; ++ai)
#pragma unroll
            for (int m = 0; m < 4; ++m) { float s = 0.f;
#pragma unroll
                for (int bj = 0; bj < 2; ++bj) s += dot4(acc[ai][bj][m][0]) + dot4(acc[ai][bj][m][1]);
                s = quad_row_sum(s);
                if (fq == 0) __hip_atomic_fetch_add(ss + row0 + ai * HALF + m * 16, s, __ATOMIC_RELAXED, __HIP_MEMORY_SCOPE_AGENT); }
        panel_sync(cnt + 64 * u.pm);
        f32x4 gv[2][2];
#pragma unroll
        for (int bj = 0; bj < 2; ++bj) { gv[bj][0] = *(const f32x4*)(g + col0 + bj * HALF); gv[bj][1] = *(const f32x4*)(g + col0 + bj * HALF + 4); }
#pragma unroll
        for (int ai = 0; ai < 2; ++ai)
#pragma unroll
            for (int m = 0; m < 4; ++m) { const int row = row0 + ai * HALF + m * 16;
                const float r1 = 1.f / sqrtf(ld_sc1(ss + row) * (1.f / 2048.f) + 1e-6f);
                float* orow = OUT + (size_t)row * 2048 + col0;
#pragma unroll
                for (int bj = 0; bj < 2; ++bj) { const u32x4 w = *(const u32x4*)(X1 + (size_t)row * 2048 + col0 + bj * HALF);
                    const f32x4 x0 = {__builtin_bit_cast(float, w.x << 16), __builtin_bit_cast(float, w.x & 0xffff0000u), __builtin_bit_cast(float, w.y << 16), __builtin_bit_cast(float, w.y & 0xffff0000u)};
                    const f32x4 x1 = {__builtin_bit_cast(float, w.z << 16), __builtin_bit_cast(float, w.z & 0xffff0000u), __builtin_bit_cast(float, w.w << 16), __builtin_bit_cast(float, w.w & 0xffff0000u)};
                    *(f32x4*)(orow + bj * HALF) = x0 + acc[ai][bj][m][0] * r1 * gv[bj][0]; *(f32x4*)(orow + bj * HALF + 4) = x1 + acc[ai][bj][m][1] * r1 * gv[bj][1]; } }
    }
};

template <class Epi, class Sched, bool ALIGN_EPI = false, bool SP2 = false>
__device__ __forceinline__ void gemm_phase(PG8_LAS unsigned char* lds, const Gemm g, const Sched& S, const Epi& E) {
    const int tid = threadIdx.x, wid = __builtin_amdgcn_readfirstlane(tid >> 6), lane = tid & 63, wr = wid >> 2, wc = wid & 3, fr = lane & 15, fq = lane >> 4;
    const int K = g.K, nt = K / BK;
    unsigned voffA[2], voffB[2];
#pragma unroll
    for (int i = 0; i < 2; ++i) { int R, C; stage_rc(tid * 16 + i * 8192, R, C); const int Rb = Epi::PERM ? ((R & ~31) + perm32(R & 31)) : R;
        voffA[i] = (unsigned)(R * K + C) * 2u; voffB[i] = (unsigned)(Rb * K + C) * 2u; }
    const size_t kstep = (size_t)(BK * 2);
    const size_t hstep = (size_t)HALF * K * 2;
    const size_t tstep = 2 * hstep;
    const unsigned ldsw = (unsigned)wid * 1024u;
    const int aoff = lds_byte(wr * 64 + fr, fq * 8), boff = lds_byte(wc * 32 + fr, fq * 8);
#define PG8_SA(b, h) (((b) * 2 + (h)) * HTB)
#define PG8_SB(b, h) ((4 + (b) * 2 + (h)) * HTB)
#define PG8_STAGE(bufoff, gbase, voff) do { _Pragma("unroll") for (int _i = 0; _i < 2; ++_i) \
        __builtin_amdgcn_global_load_lds((const unsigned*)((const char*)(gbase) + (voff)[_i]), (PG8_LAS unsigned*)(lds + (bufoff) + ldsw + _i * 8192), 16, 0, 0); } while (0)
#define PG8_LDA(dst, b, h) do { _Pragma("unroll") for (int m = 0; m < 4; ++m) _Pragma("unroll") for (int k = 0; k < 2; ++k) dst[m][k] = *(const PG8_LAS bf16x8*)(lds + PG8_SA(b, h) + aoff + m * 2048 + k * 1024); } while (0)
#define PG8_LDB(dst, b, h) do { _Pragma("unroll") for (int n = 0; n < 2; ++n) _Pragma("unroll") for (int k = 0; k < 2; ++k) dst[n][k] = *(const PG8_LAS bf16x8*)(lds + PG8_SB(b, h) + boff + n * 2048 + k * 1024); } while (0)
#define PG8_MMA(ai, bj, At, Bt) do { __builtin_amdgcn_s_setprio(1); _Pragma("unroll") for (int m = 0; m < 4; ++m) _Pragma("unroll") for (int n = 0; n < 2; ++n) _Pragma("unroll") for (int k = 0; k < 2; ++k) \
        acc[ai][bj][m][n] = __builtin_amdgcn_mfma_f32_16x16x32_bf16(Bt[n][k], At[m][k], acc[ai][bj][m][n], 0, 0, 0); __builtin_amdgcn_s_setprio(0); } while (0)
#define PG8_WAIT_V(n) asm volatile("s_waitcnt vmcnt(" #n ")" ::: "memory")
#define PG8_WAIT_L(n) asm volatile("s_waitcnt lgkmcnt(" #n ")" ::: "memory")
#define PG8_BAR __builtin_amdgcn_s_barrier()
#define PG8_SCHED __builtin_amdgcn_sched_barrier(0)
    Unit cur, nxt; int ui = 0;
    if (!S.next(0, cur)) return;
    f32x4 acc[2][2][4][2];
#pragma unroll
    for (int a = 0; a < 2; ++a)
#pragma unroll
        for (int b = 0; b < 2; ++b)
#pragma unroll
            for (int m = 0; m < 4; ++m)
#pragma unroll
                for (int n = 0; n < 2; ++n) acc[a][b][m][n] = (f32x4){0.f, 0.f, 0.f, 0.f};
    bf16x8 At[4][2], B0[2][2], B1[2][2];
    const char* cA = (const char*)g.A + (size_t)cur.pm * tstep; const char* cB = (const char*)g.Bt + (size_t)cur.pn * tstep;
    S.a_ready(cur);
    if constexpr (SP2) {
        PG8_STAGE(PG8_SB(0, 0), cB, voffB); PG8_STAGE(PG8_SB(0, 1), cB + hstep, voffB); PG8_STAGE(PG8_SA(0, 0), cA, voffA); PG8_STAGE(PG8_SA(0, 1), cA + hstep, voffA);
        if (wr == 1) PG8_BAR;
        PG8_WAIT_V(2); PG8_BAR;
        PG8_STAGE(PG8_SB(1, 0), cB + kstep, voffB); PG8_STAGE(PG8_SA(1, 0), cA + kstep, voffA); PG8_STAGE(PG8_SB(1, 1), cB + hstep + kstep, voffB);
        PG8_WAIT_V(6); PG8_BAR;
    } else {
        PG8_STAGE(PG8_SB(0, 0), cB, voffB); PG8_STAGE(PG8_SA(0, 0), cA, voffA); PG8_STAGE(PG8_SB(0, 1), cB + hstep, voffB); PG8_STAGE(PG8_SA(0, 1), cA + hstep, voffA);
        if (wr == 1) PG8_BAR;
        PG8_WAIT_V(4); PG8_BAR;
        PG8_STAGE(PG8_SB(1, 0), cB + kstep, voffB); PG8_STAGE(PG8_SA(1, 0), cA + kstep, voffA); PG8_STAGE(PG8_SB(1, 1), cB + hstep + kstep, voffB);
        PG8_WAIT_V(6); PG8_BAR;
    }
    for (;;) {
        const bool has_next = S.next(ui + 1, nxt);
        const char* nA = has_next ? (const char*)g.A + (size_t)nxt.pm * tstep : cA; const char* nB = has_next ? (const char*)g.Bt + (size_t)nxt.pn * tstep : cB;
        for (int t = 0; t < nt; t += 2) {
            const bool last = (t == nt - 2);
            const char* a1 = cA + (size_t)(t + 1) * kstep;
            const char* a2 = last ? nA : cA + (size_t)(t + 2) * kstep; const char* b2 = last ? nB : cB + (size_t)(t + 2) * kstep;
            const char* a3 = a2 + kstep; const char* b3 = b2 + kstep;
            if (last && has_next) S.a_ready(nxt);
            if constexpr (SP2) {
            PG8_LDB(B0, 0, 0); PG8_LDB(B1, 0, 1); PG8_SCHED; PG8_LDA(At, 0, 0); PG8_STAGE(PG8_SA(1, 1), a1 + hstep, voffA);
            PG8_WAIT_V(8); PG8_WAIT_L(0); PG8_BAR; PG8_MMA(0, 0, At, B0); PG8_MMA(0, 1, At, B1); PG8_BAR; PG8_SCHED;
            PG8_LDA(At, 0, 1); PG8_STAGE(PG8_SB(0, 0), b2, voffB); PG8_STAGE(PG8_SB(0, 1), b2 + hstep, voffB); PG8_STAGE(PG8_SA(0, 0), a2, voffA);
            PG8_WAIT_V(8); PG8_WAIT_L(0); PG8_BAR; PG8_MMA(1, 0, At, B0); PG8_MMA(1, 1, At, B1); PG8_BAR; PG8_SCHED;
            PG8_LDB(B0, 1, 0); PG8_LDB(B1, 1, 1); PG8_SCHED; PG8_LDA(At, 1, 0); PG8_STAGE(PG8_SA(0, 1), a2 + hstep, voffA);
            PG8_WAIT_V(8); PG8_WAIT_L(0); PG8_BAR; PG8_MMA(0, 0, At, B0); PG8_MMA(0, 1, At, B1); PG8_BAR; PG8_SCHED;
            PG8_LDA(At, 1, 1); PG8_STAGE(PG8_SB(1, 0), b3, voffB); PG8_STAGE(PG8_SB(1, 1), b3 + hstep, voffB); PG8_STAGE(PG8_SA(1, 0), a3, voffA);
            PG8_WAIT_V(8); PG8_WAIT_L(0); PG8_BAR; PG8_MMA(1, 0, At, B0); PG8_MMA(1, 1, At, B1); PG8_BAR; PG8_SCHED;
            } else {
            PG8_LDB(B0, 0, 0); PG8_SCHED; PG8_LDA(At, 0, 0); PG8_STAGE(PG8_SA(1, 1), a1 + hstep, voffA);
            PG8_WAIT_L(8); PG8_BAR; PG8_WAIT_L(0); PG8_MMA(0, 0, At, B0); PG8_BAR; PG8_SCHED;
            PG8_LDB(B1, 0, 1); PG8_STAGE(PG8_SB(0, 0), b2, voffB);
            PG8_BAR; PG8_WAIT_L(0); PG8_MMA(0, 1, At, B1); PG8_BAR;
            PG8_LDA(At, 0, 1); PG8_STAGE(PG8_SA(0, 0), a2, voffA);
            PG8_BAR; PG8_WAIT_L(0); PG8_MMA(1, 0, At, B0); PG8_BAR; PG8_SCHED;
            PG8_STAGE(PG8_SB(0, 1), b2 + hstep, voffB);
            PG8_WAIT_V(6); PG8_BAR; PG8_MMA(1, 1, At, B1); PG8_BAR;
            PG8_LDB(B0, 1, 0); PG8_SCHED; PG8_LDA(At, 1, 0); PG8_STAGE(PG8_SA(0, 1), a2 + hstep, voffA);
            PG8_WAIT_L(8); PG8_BAR; PG8_WAIT_L(0); PG8_MMA(0, 0, At, B0); PG8_BAR; PG8_SCHED;
            PG8_LDB(B1, 1, 1); PG8_STAGE(PG8_SB(1, 0), b3, voffB);
            PG8_BAR; PG8_WAIT_L(0); PG8_MMA(0, 1, At, B1); PG8_BAR;
            PG8_LDA(At, 1, 1); PG8_STAGE(PG8_SA(1, 0), a3, voffA);
            PG8_BAR; PG8_WAIT_L(0); PG8_MMA(1, 0, At, B0); PG8_BAR; PG8_SCHED;
            PG8_STAGE(PG8_SB(1, 1), b3 + hstep, voffB);
            PG8_WAIT_V(6); PG8_BAR; PG8_MMA(1, 1, At, B1); PG8_BAR;
            }
        }
        if constexpr (ALIGN_EPI) { if (wr == 0) PG8_BAR; }
        if constexpr (!Epi::AFTER_DRAIN) { E(acc, cur, wr, wc, fr, fq); S.done(cur); }
        if (!has_next) break;
#pragma unroll
        for (int a = 0; a < 2; ++a)
#pragma unroll
            for (int b = 0; b < 2; ++b)
#pragma unroll
                for (int m = 0; m < 4; ++m)
#pragma unroll
                    for (int n = 0; n < 2; ++n) acc[a][b][m][n] = (f32x4){0.f, 0.f, 0.f, 0.f};
        cur = nxt; cA = nA; cB = nB; ++ui;
        if constexpr (ALIGN_EPI) { if (wr == 1) PG8_BAR; }
    }
    PG8_WAIT_V(0);
    if constexpr (!ALIGN_EPI) { if (wr == 0) PG8_BAR; }
    PG8_BAR;
    if constexpr (Epi::AFTER_DRAIN) { E.fused(acc, cur, wr, wc, fr, fq, lds, wid, lane); S.done(cur); }
#undef PG8_SA
#undef PG8_SB
#undef PG8_STAGE
#undef PG8_LDA
#undef PG8_LDB
#undef PG8_MMA
#undef PG8_WAIT_V
#undef PG8_WAIT_L
#undef PG8_BAR
#undef PG8_SCHED
}
}

#ifndef FUSED_NORM
#define FUSED_NORM 1
#endif
#ifndef PROBE_DUP
#define PROBE_DUP 0
#endif

constexpr int DM = 2048, PW = 6144, DFF = 5632, MT = 65536, M_P = 32768, S_P = 4096, S_S = 2048;
constexpr float EPS = 1e-6f, LOG2E = 1.4426950408889634f;
constexpr float Q_SCALE_A = 0.08838834764831845f * LOG2E, Q_SCALE_B = 0.125f * LOG2E;
constexpr size_t MiB = 1u << 20;
constexpr size_t WS_WIN = 0, WS_WOUT = 24 * MiB, WS_WGU = 32 * MiB, WS_WDN = 76 * MiB;
constexpr size_t WS_TBB = 98 * MiB, WS_TBA = 98 * MiB + 512 * 1024;
constexpr size_t WS_H = 100 * MiB, WS_PROJ = 356 * MiB, WS_MIXED = 1124 * MiB, WS_Y = 1380 * MiB, WS_CTL = 1636 * MiB, WS_SS = 1636 * MiB + 256 * 1024, WS_END = 1637 * MiB;
constexpr int LDS_BYTES = 155648, BAR_LDS_OFF = 151552;

#define LAS __attribute__((address_space(3)))
typedef unsigned short bf16;
typedef short bf16x8 __attribute__((ext_vector_type(8)));
typedef short s16x4 __attribute__((ext_vector_type(4)));
typedef float f32x4 __attribute__((ext_vector_type(4)));
typedef float f32x16 __attribute__((ext_vector_type(16)));
typedef unsigned u32x4 __attribute__((ext_vector_type(4)));
typedef unsigned u32x2 __attribute__((ext_vector_type(2)));
#define LDS_WAIT() asm volatile("s_waitcnt lgkmcnt(0)" ::: "memory")
#define SBAR() __builtin_amdgcn_sched_barrier(0)
__device__ __forceinline__ unsigned cvtpk(float lo, float hi) { unsigned r; asm volatile("v_cvt_pk_bf16_f32 %0, %1, %2" : "=v"(r) : "v"(lo), "v"(hi)); return r; }
__device__ __forceinline__ unsigned f2bf(float f) { unsigned u = __builtin_bit_cast(unsigned, f); return (u + 0x7fffu + ((u >> 16) & 1u)) >> 16; }
__device__ __forceinline__ float bflo(unsigned w) { return __builtin_bit_cast(float, w << 16); }
__device__ __forceinline__ float bfhi(unsigned w) { return __builtin_bit_cast(float, w & 0xffff0000u); }
__device__ __forceinline__ float wave_sum(float v) {
#pragma unroll
    for (int o = 1; o < 64; o <<= 1) v += __shfl_xor(v, o);
    return v;
}
__device__ __forceinline__ int crow(int r, int hi) { return (r & 3) + 8 * (r >> 2) + 4 * hi; }
__device__ __forceinline__ int v_st(int k, int c) { const int kk = (k & ~0xC) | ((k & 4) << 1) | ((k & 8) >> 1); return ((kk >> 3) * 4 + (c >> 5)) * 512 + ((kk & 7) * 32 + (c & 31)) * 2; }
__device__ __forceinline__ int v_rd_base(int lane) { return ((lane & 3) << 3) | (((lane >> 2) & 3) << 6) | (((lane >> 4) & 1) << 5) | (((lane >> 5) & 1) << 8); }
constexpr int v_rd_off(int d0, int ks, int half) { return d0 * 512 + ks * 4096 + half * 2048; }
template <int OFF> __device__ __forceinline__ s16x4 tr_read(int vb) { s16x4 r; asm volatile("ds_read_b64_tr_b16 %0, %1 offset:%2" : "=&v"(r) : "v"(vb), "i"(OFF) : "memory"); return r; }
#define PKV(L, H) (bf16x8){L[0], L[1], L[2], L[3], H[0], H[1], H[2], H[3]}
#define PK4(P, BASE, OUT) do { unsigned a0 = cvtpk(P[BASE + 0], P[BASE + 1]), a1 = cvtpk(P[BASE + 2], P[BASE + 3]);   \
    unsigned b0 = cvtpk(P[BASE + 4], P[BASE + 5]), b1 = cvtpk(P[BASE + 6], P[BASE + 7]);                              \
    auto r0 = __builtin_amdgcn_permlane32_swap(a0, b0, false, false); auto r1 = __builtin_amdgcn_permlane32_swap(a1, b1, false, false); \
    u32x4 w = {r0[0], r1[0], r0[1], r1[1]}; OUT = __builtin_bit_cast(bf16x8, w); } while (0)
__device__ __forceinline__ float half_max(float v) { auto rr = __builtin_amdgcn_permlane32_swap(__float_as_uint(v), __float_as_uint(v), false, false); return fmaxf(__uint_as_float(rr[0]), __uint_as_float(rr[1])); }
__device__ __forceinline__ float half_add(float v) { auto rr = __builtin_amdgcn_permlane32_swap(__float_as_uint(v), __float_as_uint(v), false, false); return __uint_as_float(rr[0]) + __uint_as_float(rr[1]); }

__device__ __forceinline__ int rel_bucket(int rel) {
    const int n = rel < 0 ? -rel : rel;
    int b = n;
    if (n >= 8) b = 8 + (n >= 15) + (n >= 27) + (n >= 50) + (n >= 91) + (n >= 166) + (n >= 305) + (n >= 559);
    return b + (rel > 0 ? 16 : 0);
}

__device__ __forceinline__ void p0_transpose_item(const float* W, int K, int N, bf16* WT, int mode, LAS float* scr, int item, int lane) {
    const int nblk = N / 32, kb = item / nblk, nb = item % nblk, k0 = 64 * kb, n0 = 32 * nb;
#pragma unroll 8
    for (int i = 0; i < 32; ++i) { const int kk = 2 * i + (lane >> 5); scr[kk * 33 + (lane & 31)] = W[(size_t)(k0 + kk) * N + n0 + (lane & 31)]; }
    LDS_WAIT();
    const int drow0 = mode == 0 ? n0 : (256 * (n0 >> 7) + (n0 & 127) + (mode == 2 ? 128 : 0));
    const int c = lane & 7;
#pragma unroll
    for (int j = 0; j < 4; ++j) { const int n = (lane >> 3) + 8 * j; const LAS float* s = scr + (8 * c) * 33 + n;
        u32x4 o; o.x = cvtpk(s[0 * 33], s[1 * 33]); o.y = cvtpk(s[2 * 33], s[3 * 33]); o.z = cvtpk(s[4 * 33], s[5 * 33]); o.w = cvtpk(s[6 * 33], s[7 * 33]);
        *(u32x4*)(WT + (size_t)(drow0 + n) * K + k0 + 8 * c) = o; }
    LDS_WAIT();
}
__device__ __forceinline__ const float* xrow_ptr(const float* xp, const float* xs, int m) { return m < M_P ? xp + (size_t)m * DM : xs + (size_t)(m - M_P) * DM; }
__device__ __forceinline__ void prenorm_row(const float* xrow, const float* g, bf16* orow, int lane) {
    const f32x4* xr = (const f32x4*)xrow + lane; f32x4 v[8]; float s = 0.f;
#pragma unroll
    for (int j = 0; j < 8; ++j) { v[j] = xr[64 * j]; s += (v[j].x * v[j].x + v[j].y * v[j].y) + (v[j].z * v[j].z + v[j].w * v[j].w); }
    const float r = 1.f / sqrtf(wave_sum(s) * (1.f / DM) + EPS);
    u32x2* o8 = (u32x2*)orow + lane;
#pragma unroll
    for (int j = 0; j < 8; ++j) { const f32x4 gv = ((const f32x4*)g)[lane + 64 * j]; u32x2 w; w.x = cvtpk(v[j].x * r * gv.x, v[j].y * r * gv.y); w.y = cvtpk(v[j].z * r * gv.z, v[j].w * r * gv.w); o8[64 * j] = w; }
}

namespace mixa {
constexpr int KB_OFF = 65536, TBA_OFF = 131072, SSQ_OFF = 143872, LI_OFF = 145920;
template <int D0> __device__ __forceinline__ void pv_one(f32x16& od, int vb, bf16x8 pa0, bf16x8 pa1) {
    s16x4 l0 = tr_read<v_rd_off(D0, 0, 0)>(vb), h0 = tr_read<v_rd_off(D0, 0, 1)>(vb), l1 = tr_read<v_rd_off(D0, 1, 0)>(vb), h1 = tr_read<v_rd_off(D0, 1, 1)>(vb);
    asm volatile("s_waitcnt lgkmcnt(0)" : "+v"(l0), "+v"(h0), "+v"(l1), "+v"(h1) :: "memory");
    od = __builtin_amdgcn_mfma_f32_32x32x16_bf16(pa0, PKV(l0, h0), od, 0, 0, 0);
    od = __builtin_amdgcn_mfma_f32_32x32x16_bf16(pa1, PKV(l1, h1), od, 0, 0, 0);
}
template <int MODE>
__device__ __forceinline__ void phase(LAS unsigned char* lds, const bf16* __restrict__ PROJ, bf16* __restrict__ MIXED, const float* __restrict__ tbA_g, const float* __restrict__ norm_a_g, bf16* PO, float* PML, int G, int vcu) {
    constexpr int NT = MODE ? 13 : 5;
    const int tid = threadIdx.x, wid = __builtin_amdgcn_readfirstlane(tid >> 6), lane = tid & 63, r32 = lane & 31, hi = lane >> 5;
    const int h = wid;
    LAS float* tb = (LAS float*)(lds + TBA_OFF);
    for (int i = tid; i < 3 * 8 * 132; i += 512) tb[i] = tbA_g[i];
    __syncthreads();
    LAS unsigned char* vbuf = lds + wid * 8192;
    LAS unsigned char* kbuf = lds + KB_OFF + wid * 8192;
    const int vb0 = (int)(uintptr_t)vbuf + v_rd_base(lane);
    LAS float* ssq = (LAS float*)(lds + SSQ_OFF); LAS float* li_l = (LAS float*)(lds + LI_OFF) + wid * 64; LAS float* al_l = li_l + 32;
    const int vq = lane >> 4, vc = (lane & 15) * 8;
    const int vst_lane = (vc >> 5) * 512 + (vq * 32 + (vc & 31)) * 2;
    int par = 0;
    for (int unit = vcu; unit < 2048; unit += G, par ^= 1) {
        int r, R0, S, T0, Q0;
        if (MODE) { r = unit & 15; const int grp = unit >> 4; int blk;
            if (grp < 64) { R0 = (grp >> 3) * S_P; S = S_P; blk = grp & 7; } else { const int g2 = grp - 64; R0 = M_P + (g2 >> 2) * S_S; S = S_S; blk = g2 & 3; }
            T0 = 32 * blk; Q0 = 0; }
        else { r = 0; T0 = 0;
            if (unit < 1024) { R0 = (unit >> 7) * S_P; S = S_P; Q0 = 32 * (unit & 127); } else { const int u2 = unit - 1024; R0 = M_P + (u2 >> 6) * S_S; S = S_S; Q0 = 32 * (u2 & 63); } }
#define MA_QROW(i) (MODE ? R0 + 16 * (T0 + (i)) + r : R0 + Q0 + (i))
        const bf16* qp = PROJ + (size_t)MA_QROW(r32) * PW + h * 128 + hi * 8;
        bf16x8 qr[8];
#pragma unroll
        for (int d0 = 0; d0 < 8; ++d0) qr[d0] = *(const bf16x8*)(qp + d0 * 16);
        f32x16 o[4];
#pragma unroll
        for (int d = 0; d < 4; ++d)
#pragma unroll
            for (int i = 0; i < 16; ++i) o[d][i] = 0.f;
        float m_reg = -1e30f, l_reg = 0.f;
        if (MODE) {
            const float2 ml = *(const float2*)(PML + ((size_t)MA_QROW(r32) * 8 + h) * 2); m_reg = ml.x; l_reg = ml.y;
#pragma unroll
            for (int i = 0; i < 16; ++i) { const u32x2 w = *(const u32x2*)(PO + (size_t)MA_QROW(crow(i, hi)) * 1024 + h * 128 + r32 * 4);
                o[0][i] = bflo(w.x); o[1][i] = bfhi(w.x); o[2][i] = bflo(w.y); o[3][i] = bfhi(w.y); }
        }
        bf16x8 kf[8], vs[8];
        const bf16* vbase = PROJ + (size_t)R0 * PW + 2048 + h * 128 + vc;
#define MA_DESC(tix) const int br = MODE ? ((tix) >= 5) : 2, jj = MODE ? (tix) - (br ? 5 : 0) : (tix), sh = 4 - 2 * br, dd = 1 << sh, rd = r & (dd - 1), rq = r >> sh, \
        u0 = (MODE ? (T0 << (4 - sh)) + rq : Q0) - 64 + 32 * jj
#define MA_LOAD(tix) do { MA_DESC(tix); \
        _Pragma("unroll") for (int i8 = 0; i8 < 8; ++i8) { int pos = (u0 + 4 * i8 + vq) * dd + rd; pos = pos < 0 ? 0 : (pos > S - 1 ? S - 1 : pos); const bf16* vp = vbase + (size_t)pos * PW; \
            vs[i8] = *(const bf16x8*)vp; kf[i8] = *(const bf16x8*)(vp - 1024); } } while (0)
        MA_LOAD(0);
        for (int tix = 0; tix < NT; ++tix) {
            MA_DESC(tix);
#pragma unroll
            for (int i8 = 0; i8 < 8; ++i8) { *(LAS bf16x8*)(vbuf + vst_lane + ((i8 & 1) + 2 * (i8 >> 2)) * 2048 + ((i8 >> 1) & 1) * 256) = vs[i8];
                *(LAS bf16x8*)(kbuf + (4 * i8 + vq) * 256 + ((vc * 2) ^ (((4 * i8 + vq) & 7) << 4))) = kf[i8]; }
            f32x16 p;
#pragma unroll
            for (int i = 0; i < 16; ++i) p[i] = 0.f;
#pragma unroll
            for (int d0 = 0; d0 < 8; ++d0) { const bf16x8 ka = *(const LAS bf16x8*)(kbuf + r32 * 256 + (((d0 * 16 + hi * 8) * 2) ^ ((r32 & 7) << 4)));
                p = __builtin_amdgcn_mfma_f32_32x32x16_bf16(ka, qr[d0], p, 0, 0, 0); if (d0 == 3) SBAR(); }
            SBAR();
            const int Ld = S >> sh, ti = MODE ? ((T0 + r32) << (4 - sh)) + rq : Q0 + r32, base = u0 + 4 * hi - ti;
            const LAS float* tbh = tb + (br * 8 + h) * 132 + 65;
            const bool edge = (u0 < 0) || (u0 + 32 > Ld);
#pragma unroll
            for (int i = 0; i < 16; ++i) { int ru = base + (i & 3) + 8 * (i >> 2); ru = ru < -65 ? -65 : (ru > 65 ? 65 : ru); p[i] += tbh[ru]; }
            if (edge) {
#pragma unroll
                for (int i = 0; i < 16; ++i) { const int uu = u0 + 4 * hi + (i & 3) + 8 * (i >> 2); if (uu < 0 || uu >= Ld) p[i] = -__builtin_inff(); }
            }
            float pmax = p[0];
#pragma unroll
            for (int i = 1; i < 16; ++i) pmax = fmaxf(pmax, p[i]);
            pmax = half_max(pmax);
            float mn, alpha;
            if (__all(pmax - m_reg <= 8.f)) { mn = m_reg; alpha = 1.f; }
            else { mn = fmaxf(m_reg, pmax); alpha = __builtin_amdgcn_exp2f(m_reg - mn); m_reg = mn; }
            float ps = 0.f;
#pragma unroll
            for (int i = 0; i < 16; ++i) { p[i] = __builtin_amdgcn_exp2f(p[i] - mn); ps += p[i]; }
            ps = half_add(ps);
            l_reg = l_reg * alpha + ps;
            if (__any(alpha < 1.f)) { if (hi == 0) al_l[r32] = alpha; LDS_WAIT();
#pragma unroll
                for (int i = 0; i < 16; ++i) { const float a = al_l[crow(i, hi)];
#pragma unroll
                    for (int d = 0; d < 4; ++d) o[d][i] *= a; } }
            bf16x8 pa0, pa1; PK4(p, 0, pa0); PK4(p, 8, pa1);
            if (tix + 1 < NT) MA_LOAD(tix + 1);
            pv_one<0>(o[0], vb0, pa0, pa1); pv_one<1>(o[1], vb0, pa0, pa1); pv_one<2>(o[2], vb0, pa0, pa1); pv_one<3>(o[3], vb0, pa0, pa1);
        }
#undef MA_LOAD
#undef MA_DESC
        if (!MODE) {
            if (hi == 0) *(float2*)(PML + ((size_t)MA_QROW(r32) * 8 + h) * 2) = make_float2(m_reg, l_reg);
#pragma unroll
            for (int i = 0; i < 16; ++i) { u32x2 w; w.x = cvtpk(o[0][i], o[1][i]); w.y = cvtpk(o[2][i], o[3][i]);
                *(u32x2*)(PO + (size_t)MA_QROW(crow(i, hi)) * 1024 + h * 128 + r32 * 4) = w; }
            continue;
        }
        if (hi == 0) li_l[r32] = l_reg; LDS_WAIT();
        float sq[16];
#pragma unroll
        for (int i = 0; i < 16; ++i) { const float rl = __builtin_amdgcn_rcpf(li_l[crow(i, hi)]); float s = 0.f;
#pragma unroll
            for (int d = 0; d < 4; ++d) { o[d][i] *= rl; s += o[d][i] * o[d][i]; }
            sq[i] = s; }
#pragma unroll
        for (int off = 1; off < 32; off <<= 1)
#pragma unroll
            for (int i = 0; i < 16; ++i) sq[i] += __shfl_xor(sq[i], off);
        LAS float* sp = ssq + par * 256;
        if (r32 == 0) {
#pragma unroll
            for (int i = 0; i < 16; ++i) sp[h * 32 + crow(i, hi)] = sq[i]; }
        __syncthreads();
        float gv[4];
#pragma unroll
        for (int d = 0; d < 4; ++d) gv[d] = norm_a_g[h * 128 + 32 * d + r32];
#pragma unroll
        for (int i = 0; i < 16; ++i) { const int qi = crow(i, hi); float tot = 0.f;
#pragma unroll
            for (int hh = 0; hh < 8; ++hh) tot += sp[hh * 32 + qi];
            const float rs = 1.f / sqrtf(tot * (1.f / 1024.f) + EPS);
            bf16* op = MIXED + (size_t)MA_QROW(qi) * DM + h * 128 + r32;
#pragma unroll
            for (int d = 0; d < 4; ++d) op[32 * d] = (bf16)f2bf(o[d][i] * rs * gv[d]); }
    }
#undef MA_QROW
    __syncthreads();
}
}

namespace mixb {
constexpr int SHM_V = 16384, SHM_K = 16384, TB_OFF = 65536, WS_OFF = 98304;
#define KSWZ(row, colB) ((row) * 256 + ((colB) ^ (((row) & 7) << 4)))
__device__ __forceinline__ void partialSM(f32x16& p0, f32x16& p1, const LAS float* tbp, int relc, float cL, float cR, float& m_reg, float& mn, float& alpha) {
    float cb = 0.f;
    if (relc + 63 <= -559) cb = cL;
    else if (relc - 31 >= 559) cb = cR;
    else {
#pragma unroll
        for (int r = 0; r < 16; ++r) { p0[r] += tbp[(r & 3) + 8 * (r >> 2)]; p1[r] += tbp[32 + (r & 3) + 8 * (r >> 2)]; }
    }
    float pmax = p0[0];
#pragma unroll
    for (int r = 1; r < 16; ++r) pmax = fmaxf(pmax, p0[r]);
#pragma unroll
    for (int r = 0; r < 16; ++r) pmax = fmaxf(pmax, p1[r]);
    pmax = half_max(pmax) + cb;
    if (__builtin_expect(__all(pmax - m_reg <= 8.f), 1)) { mn = m_reg; alpha = 1.f; }
    else { mn = fmaxf(m_reg, pmax); alpha = __builtin_amdgcn_exp2f(m_reg - mn); m_reg = mn; }
    const float sh = mn - cb;
#pragma unroll
    for (int r = 0; r < 16; ++r) { p0[r] -= sh; p1[r] -= sh; }
#pragma unroll
    for (int r = 0; r < 16; ++r) p0[r] = __builtin_amdgcn_exp2f(p0[r]);
}
__device__ __forceinline__ void finishSM(f32x16& p0, f32x16& p1, float alpha, float& l_reg, bf16x8& pa0, bf16x8& pa1, bf16x8& pa2, bf16x8& pa3) {
#pragma unroll
    for (int r = 0; r < 16; ++r) p1[r] = __builtin_amdgcn_exp2f(p1[r]);
    float ps = 0;
#pragma unroll
    for (int r = 0; r < 16; ++r) ps += p0[r];
#pragma unroll
    for (int r = 0; r < 16; ++r) ps += p1[r];
    ps = half_add(ps);
    l_reg = l_reg * alpha + ps;
    PK4(p0, 0, pa0); PK4(p0, 8, pa1); PK4(p1, 0, pa2); PK4(p1, 8, pa3);
}
__device__ __forceinline__ void qkt(f32x16& p0, f32x16& p1, const LAS unsigned char* Ks, const bf16x8* qr, int r32, int cb0) {
#pragma unroll
    for (int i = 0; i < 16; ++i) { p0[i] = 0.f; p1[i] = 0.f; }
#pragma unroll
    for (int d0 = 0; d0 < 4; ++d0) { const int cb = cb0 + d0 * 32;
        const bf16x8 b0 = *(const LAS bf16x8*)(Ks + KSWZ(r32, cb));
        const bf16x8 b1 = *(const LAS bf16x8*)(Ks + KSWZ(32 + r32, cb));
        p0 = __builtin_amdgcn_mfma_f32_32x32x16_bf16(b0, qr[d0], p0, 0, 0, 0);
        p1 = __builtin_amdgcn_mfma_f32_32x32x16_bf16(b1, qr[d0], p1, 0, 0, 0); }
}
template <int D0> __device__ __forceinline__ void pv_one(f32x16& od, int vb, bf16x8 pa0, bf16x8 pa1, bf16x8 pa2, bf16x8 pa3) {
    s16x4 l0 = tr_read<v_rd_off(D0, 0, 0)>(vb), h0 = tr_read<v_rd_off(D0, 0, 1)>(vb), l1 = tr_read<v_rd_off(D0, 1, 0)>(vb), h1 = tr_read<v_rd_off(D0, 1, 1)>(vb);
    s16x4 l2 = tr_read<v_rd_off(D0, 2, 0)>(vb), h2 = tr_read<v_rd_off(D0, 2, 1)>(vb), l3 = tr_read<v_rd_off(D0, 3, 0)>(vb), h3 = tr_read<v_rd_off(D0, 3, 1)>(vb);
    asm volatile("s_waitcnt lgkmcnt(0)" : "+v"(l0), "+v"(h0), "+v"(l1), "+v"(h1), "+v"(l2), "+v"(h2), "+v"(l3), "+v"(h3) :: "memory");
    od = __builtin_amdgcn_mfma_f32_32x32x16_bf16(pa0, PKV(l0, h0), od, 0, 0, 0);
    od = __builtin_amdgcn_mfma_f32_32x32x16_bf16(pa1, PKV(l1, h1), od, 0, 0, 0);
    od = __builtin_amdgcn_mfma_f32_32x32x16_bf16(pa2, PKV(l2, h2), od, 0, 0, 0);
    od = __builtin_amdgcn_mfma_f32_32x32x16_bf16(pa3, PKV(l3, h3), od, 0, 0, 0);
}
__device__ __forceinline__ void pv_d0(f32x16* o, int vb, bf16x8 pa0, bf16x8 pa1, bf16x8 pa2, bf16x8 pa3) {
    pv_one<0>(o[0], vb, pa0, pa1, pa2, pa3); pv_one<1>(o[1], vb, pa0, pa1, pa2, pa3); pv_one<2>(o[2], vb, pa0, pa1, pa2, pa3); pv_one<3>(o[3], vb, pa0, pa1, pa2, pa3);
}
__device__ __forceinline__ void unit(LAS unsigned char* lds, const bf16* __restrict__ PROJ, bf16* __restrict__ MIXED, const float* __restrict__ subln_g, float lam, int R0, int seq, int h, int qb) {
    const int tid = threadIdx.x, wid = __builtin_amdgcn_readfirstlane(tid >> 6), lane = tid & 63, r32 = lane & 31, hi = lane >> 5;
    const int g = wid >> 1, c = wid & 1;
    LAS unsigned char* V_lds = lds; LAS unsigned char* K_lds = lds + 2 * SHM_V;
    const LAS float* tb = (const LAS float*)(lds + TB_OFF);
    LAS float* ws = (LAS float*)(lds + WS_OFF) + wid * 64; LAS float* li_l = ws; LAS float* al_l = ws + 32;
    float m_reg = -1e30f, l_reg = 0.f; f32x16 o[4]; bf16x8 qr[4];
#pragma unroll
    for (int d = 0; d < 4; ++d)
#pragma unroll
        for (int i = 0; i < 16; ++i) o[d][i] = 0.f;
    const int qrow = 128 * qb + 32 * g + r32;
    const bf16* Qw = PROJ + (size_t)(R0 + qrow) * PW + 3072 + h * 128 + c * 64 + hi * 8;
#pragma unroll
    for (int d0 = 0; d0 < 4; ++d0) qr[d0] = *(const bf16x8*)(Qw + d0 * 16);
    const bf16* Kh = PROJ + (size_t)R0 * PW + 4096 + h * 128; const bf16* Vh = PROJ + (size_t)R0 * PW + 5120 + h * 128;
    const int sr = tid >> 4, sc = (tid & 15) * 8, vst0 = v_st(sr, sc), vst1 = v_st(32 + sr, sc);
    const int vb0 = (int)(uintptr_t)V_lds + v_rd_base(lane);
    const int cb0 = (c * 64 + hi * 8) * 2;
    const LAS float* tbq = tb + (4095 - qrow + 4 * hi);
    const int rc0 = -(128 * qb + 32 * g);
    const float cL = tb[0], cR = tb[8190];
    struct { bf16x8 vs0, vs1, ks0, ks1; } sr_[2];
#define SLOAD(i, k0) do { sr_[i].vs0 = *(const bf16x8*)(Vh + (size_t)((k0) + sr) * PW + sc); sr_[i].vs1 = *(const bf16x8*)(Vh + (size_t)((k0) + 32 + sr) * PW + sc); \
    sr_[i].ks0 = *(const bf16x8*)(Kh + (size_t)((k0) + sr) * PW + sc); sr_[i].ks1 = *(const bf16x8*)(Kh + (size_t)((k0) + 32 + sr) * PW + sc); } while (0)
#define SWRITE(b, i) do { *(LAS bf16x8*)(V_lds + (b) * SHM_V + vst0) = sr_[i].vs0; *(LAS bf16x8*)(V_lds + (b) * SHM_V + vst1) = sr_[i].vs1; const int kc = sc * 2; \
    *(LAS bf16x8*)(K_lds + (b) * SHM_K + KSWZ(sr, kc)) = sr_[i].ks0; *(LAS bf16x8*)(K_lds + (b) * SHM_K + KSWZ(32 + sr, kc)) = sr_[i].ks1; } while (0)
#define SWAIT() asm volatile("s_waitcnt vmcnt(4)" ::: "memory")
#define RESC(a) do { if (__any((a) < 1.f)) { if (hi == 0) al_l[r32] = (a); LDS_WAIT(); \
    _Pragma("unroll") for (int r = 0; r < 16; ++r) { const float av = al_l[crow(r, hi)]; _Pragma("unroll") for (int d = 0; d < 4; ++d) o[d][r] *= av; } } } while (0)
    f32x16 pA0, pA1, pB0, pB1; float mnA, mnB, alA, alB; bf16x8 pa0, pa1, pa2, pa3; const int NT = seq / 64;
    constexpr int SE = 0, SO = 1;
    SLOAD(SE, 0); SLOAD(SO, 64); SWAIT(); SWRITE(0, SE); SLOAD(SE, 128); SWAIT(); SWRITE(1, SO); __syncthreads();
    qkt(pA0, pA1, K_lds, qr, r32, cb0); partialSM(pA0, pA1, tbq, rc0, cL, cR, m_reg, mnA, alA);
    for (int j = 1; j + 1 < NT; j += 2) {
        SBAR(); qkt(pB0, pB1, K_lds + SHM_K, qr, r32, cb0);
        finishSM(pA0, pA1, alA, l_reg, pa0, pa1, pa2, pa3); SBAR();
        SLOAD(SO, (j + 2) * 64); SBAR();
        pv_d0(o, vb0, pa0, pa1, pa2, pa3); partialSM(pB0, pB1, tbq + j * 64, rc0 + j * 64, cL, cR, m_reg, mnB, alB);
        __syncthreads(); SWAIT(); SWRITE(0, SE);
        RESC(alB); __syncthreads();
        SBAR(); qkt(pA0, pA1, K_lds, qr, r32, cb0);
        finishSM(pB0, pB1, alB, l_reg, pa0, pa1, pa2, pa3); SBAR();
        if (j + 3 < NT) SLOAD(SE, (j + 3) * 64); SBAR();
        pv_d0(o, vb0 + SHM_V, pa0, pa1, pa2, pa3); partialSM(pA0, pA1, tbq + (j + 1) * 64, rc0 + (j + 1) * 64, cL, cR, m_reg, mnA, alA);
        __syncthreads(); SWAIT(); SWRITE(1, SO);
        RESC(alA); __syncthreads();
    }
    SBAR(); qkt(pB0, pB1, K_lds + SHM_K, qr, r32, cb0);
    finishSM(pA0, pA1, alA, l_reg, pa0, pa1, pa2, pa3); SBAR();
    pv_d0(o, vb0, pa0, pa1, pa2, pa3); partialSM(pB0, pB1, tbq + (NT - 1) * 64, rc0 + (NT - 1) * 64, cL, cR, m_reg, mnB, alB);
    __syncthreads(); RESC(alB);
    finishSM(pB0, pB1, alB, l_reg, pa0, pa1, pa2, pa3); SBAR();
    pv_d0(o, vb0 + SHM_V, pa0, pa1, pa2, pa3);
#undef SLOAD
#undef SWRITE
#undef SWAIT
#undef RESC
    if (hi == 0) li_l[r32] = l_reg; LDS_WAIT();
    float rli[16];
#pragma unroll
    for (int r = 0; r < 16; ++r) rli[r] = __builtin_amdgcn_rcpf(li_l[crow(r, hi)]);
    __syncthreads();
    LAS float* xch = (LAS float*)lds + g * 4096;
    if (c == 1) {
#pragma unroll
        for (int d = 0; d < 4; ++d)
#pragma unroll
            for (int r = 0; r < 16; ++r) xch[(d * 16 + r) * 64 + lane] = o[d][r] * rli[r]; }
    __syncthreads();
    if (c == 0) {
        float sq[16];
#pragma unroll
        for (int r = 0; r < 16; ++r) { float s = 0.f;
#pragma unroll
            for (int d = 0; d < 4; ++d) { const float a = o[d][r] * rli[r] - lam * xch[(d * 16 + r) * 64 + lane]; o[d][r] = a; s += a * a; }
            sq[r] = s; }
#pragma unroll
        for (int off = 1; off < 32; off <<= 1)
#pragma unroll
            for (int r = 0; r < 16; ++r) sq[r] += __shfl_xor(sq[r], off);
        float gv[4];
#pragma unroll
        for (int d = 0; d < 4; ++d) gv[d] = subln_g[32 * d + r32] * 0.8f;
#pragma unroll
        for (int r = 0; r < 16; ++r) { const float rs = 1.f / sqrtf(sq[r] * (1.f / 128.f) + EPS);
            bf16* op = MIXED + (size_t)(R0 + 128 * qb + 32 * g + crow(r, hi)) * DM + 1024 + h * 128 + r32;
#pragma unroll
            for (int d = 0; d < 4; ++d) op[32 * d] = (bf16)f2bf(o[d][r] * rs * gv[d]); }
    }
    __syncthreads();
}
__device__ __forceinline__ void phase(LAS unsigned char* lds, const bf16* __restrict__ PROJ, bf16* __restrict__ MIXED, const float* __restrict__ tbB_g, const float* __restrict__ subln_g, float lam, int G, int vcu) {
    const int tid = threadIdx.x; int h_lds = -1;
    for (int n = vcu; n < 4096; n += G) {
        const int i = n >> 8, v = n & 255, x = v >> 5, loc = v & 31;
        int R0, seq, h, qb;
        if (i < 8) { const int bh = 8 * i + x; R0 = (bh >> 3) * S_P; seq = S_P; h = bh & 7; qb = loc; }
        else { const int bh = 16 * (i - 8) + 2 * x + (loc >> 4); R0 = M_P + (bh >> 3) * S_S; seq = S_S; h = bh & 7; qb = loc & 15; }
        if (h != h_lds) {
            LAS f32x4* tb4 = (LAS f32x4*)(lds + TB_OFF); const f32x4* src = (const f32x4*)(tbB_g + h * 8192);
            for (int k = tid; k < 2048; k += 512) tb4[k] = src[k];
            h_lds = h;
            __syncthreads();
        }
        unit(lds, PROJ, MIXED, subln_g, lam, R0, seq, h, qb);
    }
}
}

__device__ __forceinline__ void p4_row(const float* xrow, const bf16* yrow, const float* g1, const float* g2, float* orow, bf16* hrow, int lane) {
    f32x4 v[8]; float s = 0.f;
#pragma unroll
    for (int j = 0; j < 8; ++j) { const u32x2 w = ((const u32x2*)yrow)[lane + 64 * j]; v[j] = (f32x4){bflo(w.x), bfhi(w.x), bflo(w.y), bfhi(w.y)}; s += (v[j].x * v[j].x + v[j].y * v[j].y) + (v[j].z * v[j].z + v[j].w * v[j].w); }
    const float r1 = 1.f / sqrtf(wave_sum(s) * (1.f / DM) + EPS); float s2 = 0.f;
#pragma unroll
    for (int j = 0; j < 8; ++j) { const f32x4 xv = ((const f32x4*)xrow)[lane + 64 * j], gv = ((const f32x4*)g1)[lane + 64 * j];
        v[j] = xv + v[j] * r1 * gv; ((f32x4*)orow)[lane + 64 * j] = v[j]; s2 += (v[j].x * v[j].x + v[j].y * v[j].y) + (v[j].z * v[j].z + v[j].w * v[j].w); }
    const float r2 = 1.f / sqrtf(wave_sum(s2) * (1.f / DM) + EPS);
#pragma unroll
    for (int j = 0; j < 8; ++j) { const f32x4 gv = ((const f32x4*)g2)[lane + 64 * j]; u32x2 w; w.x = cvtpk(v[j].x * r2 * gv.x, v[j].y * r2 * gv.y); w.y = cvtpk(v[j].z * r2 * gv.z, v[j].w * r2 * gv.w); ((u32x2*)hrow)[lane + 64 * j] = w; }
}
__device__ __forceinline__ void p7_row(const bf16* frow, const float* g, float* orow, int lane) {
    f32x4 v[8]; float s = 0.f;
#pragma unroll
    for (int j = 0; j < 8; ++j) { const u32x2 w = ((const u32x2*)frow)[lane + 64 * j]; v[j] = (f32x4){bflo(w.x), bfhi(w.x), bflo(w.y), bfhi(w.y)}; s += (v[j].x * v[j].x + v[j].y * v[j].y) + (v[j].z * v[j].z + v[j].w * v[j].w); }
    const float r1 = 1.f / sqrtf(wave_sum(s) * (1.f / DM) + EPS);
#pragma unroll
    for (int j = 0; j < 8; ++j) { const f32x4 xv = ((const f32x4*)orow)[lane + 64 * j], gv = ((const f32x4*)g)[lane + 64 * j]; ((f32x4*)orow)[lane + 64 * j] = xv + v[j] * r1 * gv; }
}

#define XB_TMO      128
#define XB_XCNT(j)  (256  + 64 * (j))
#define XB_XSUB(j)  (1280 + 64 * (j))
#define XB_XGEN(j)  (2304 + 64 * (j))
#define XB_TOP      3328
#define XB_TOPGEN   3392
#define XCD_BAR_WORDS 3456
#define XB_SPIN_CAP (1u << 18)

__device__ __forceinline__ unsigned xb_ld(unsigned* p)              { return __hip_atomic_load(p, __ATOMIC_RELAXED, __HIP_MEMORY_SCOPE_AGENT); }
__device__ __forceinline__ unsigned xb_add(unsigned* p, unsigned v) { return __hip_atomic_fetch_add(p, v, __ATOMIC_RELAXED, __HIP_MEMORY_SCOPE_AGENT); }
__device__ __forceinline__ unsigned xb_xcc_id() { return (unsigned)__builtin_amdgcn_s_getreg((3 << 11) | 20) & 0xFu; }
#define XB_SPIN(cond, bar) do { unsigned _sp = 0; while (cond) { __builtin_amdgcn_s_sleep(1); \
    if ((++_sp & 255u) == 0u) { if (xb_ld(&(bar)[XB_TMO])) break; if (_sp > XB_SPIN_CAP) { atomicAdd(&(bar)[XB_TMO], 1u); break; } } } } while (0)

struct XcdBarrier {
    unsigned* bar; unsigned x;
    volatile LAS unsigned* st;
};

__device__ __forceinline__ XcdBarrier xcd_barrier_post(unsigned* bar, volatile LAS unsigned* st) {
    XcdBarrier b; b.bar = bar; b.x = xb_xcc_id(); b.st = st;
    if (threadIdx.x == 0) (void)xb_add(&bar[XB_XCNT(b.x)], 1u);
    return b;
}
__device__ __forceinline__ void xcd_barrier_complete(unsigned* bar, unsigned x, unsigned& nloc, unsigned& nx) {
    const unsigned G = gridDim.x * gridDim.y * gridDim.z;
    unsigned sum, cnt, mine, sp = 0u;
    for (;;) {
        sum = 0u; cnt = 0u; mine = 0u;
#pragma unroll
        for (unsigned j = 0; j < 16; ++j) { const unsigned c = xb_ld(&bar[XB_XCNT(j)]); sum += c; cnt += (c > 0u) ? 1u : 0u; mine = (j == x) ? c : mine; }
        if (sum == G) break;
        __builtin_amdgcn_s_sleep(1);
        if ((++sp & 255u) == 0u) { if (xb_ld(&bar[XB_TMO])) break; if (sp > XB_SPIN_CAP) { atomicAdd(&bar[XB_TMO], 1u); break; } }
    }
    nloc = mine > 0u ? mine : 1u; nx = cnt > 0u ? cnt : 1u;
}

__device__ __forceinline__ void xcd_barrier(const XcdBarrier& b) {
    asm volatile("s_waitcnt vmcnt(0)" ::: "memory");
    __syncthreads();
    if (threadIdx.x == 0) {
        unsigned* bar = b.bar;
        __builtin_amdgcn_s_waitcnt(0);
        unsigned nloc = b.st[0], nx = b.st[1];
        if (nloc == 0u) { xcd_barrier_complete(bar, b.x, nloc, nx); b.st[0] = nloc; b.st[1] = nx; }
        const unsigned old = xb_add(&bar[XB_XSUB(b.x)], 1u);
        const unsigned gen = old / nloc;
        if (old + 1u == (gen + 1u) * nloc) {
            __builtin_amdgcn_fence(__ATOMIC_RELEASE, "agent");
            asm volatile("s_waitcnt vmcnt(0)" ::: "memory");
            const unsigned og = xb_add(&bar[XB_TOP], 1u);
            const unsigned tg = og / nx;
            if (og + 1u == (tg + 1u) * nx) xb_add(&bar[XB_TOPGEN], 1u);
            else XB_SPIN(xb_ld(&bar[XB_TOPGEN]) == tg, bar);
            __builtin_amdgcn_fence(__ATOMIC_ACQUIRE, "agent");
            xb_add(&bar[XB_XGEN(b.x)], 1u);
            asm volatile("s_waitcnt vmcnt(0)" ::: "memory");
        } else {
            XB_SPIN(xb_ld(&bar[XB_XGEN(b.x)]) == gen, bar);
            __builtin_amdgcn_fence(__ATOMIC_ACQUIRE, "agent");
            asm volatile("s_waitcnt vmcnt(0)" ::: "memory");
        }
    }
    __syncthreads();
}

struct Args { const float* in[18]; float* out; unsigned char* ws; int ph_lo, ph_hi; };
constexpr int N_PHASES = 8;
__global__ void __launch_bounds__(512, 2) fwd_mega(Args a) {
    extern __shared__ __attribute__((aligned(16))) unsigned char lds_raw[];
    LAS unsigned char* lds = (LAS unsigned char*)lds_raw;
    cg::grid_group grid = cg::this_grid();
    const int tid = threadIdx.x, lane = tid & 63, wave = __builtin_amdgcn_readfirstlane(tid >> 6);
    const int G = gridDim.x, bx = blockIdx.x;
    const int vcu = (G % 8 == 0) ? (bx % 8) * (G / 8) + bx / 8 : bx;
    const int lo = a.ph_lo, hi = a.ph_hi;
    unsigned char* ws = a.ws;
    bf16* WIN = (bf16*)(ws + WS_WIN); bf16* WOUT = (bf16*)(ws + WS_WOUT); bf16* WGU = (bf16*)(ws + WS_WGU); bf16* WDN = (bf16*)(ws + WS_WDN);
    float* TBB = (float*)(ws + WS_TBB); float* TBA = (float*)(ws + WS_TBA); float* SS = (float*)(ws + WS_SS);
    unsigned* PCNT = (unsigned*)(ws + WS_CTL + 16384);
    bf16* H = (bf16*)(ws + WS_H); bf16* PROJ = (bf16*)(ws + WS_PROJ); bf16* F = PROJ; bf16* MIXED = (bf16*)(ws + WS_MIXED); bf16* Y = (bf16*)(ws + WS_Y);
    const int gw = vcu * 8 + wave, NGW = G * 8;
#ifndef PH_MASK
#define PH_MASK 0x3ff
#endif
#define IN(k) (((PH_MASK >> (k)) & 1) && lo <= (k) && (k) < hi)
#define SEAM(k) do { if (IN(k) && IN((k) + 1)) xcd_barrier(bar); } while (0)
    XcdBarrier bar; bar.bar = (unsigned*)(ws + WS_CTL); bar.x = 0; bar.st = (volatile LAS unsigned*)(lds + BAR_LDS_OFF);
    if (hi - lo > 1) {
        if (tid < 2) ((volatile LAS unsigned*)(lds + BAR_LDS_OFF))[tid] = 0u;
        __syncthreads();
        bar = xcd_barrier_post((unsigned*)(ws + WS_CTL), (volatile LAS unsigned*)(lds + BAR_LDS_OFF));
    }
    if (hi > 1000) grid.sync();

    for (int p0rep = 0; p0rep < ((PROBE_DUP & 8) ? 2 : 1); ++p0rep)
    if (IN(0)) {
        LAS float* scr = (LAS float*)(lds + wave * 16384);
        constexpr int I_IN = (DM / 64) * (PW / 32), I_OUT = (DM / 64) * (DM / 32), I_G = (DM / 64) * (DFF / 32), I_D = (DFF / 64) * (DM / 32);
        constexpr int NITEMS = I_IN + I_OUT + 2 * I_G + I_D;
        for (int it = gw; it < NITEMS; it += NGW) {
            int r = it;
            if (r < I_IN) { p0_transpose_item(a.in[6], DM, PW, WIN, 0, scr, r, lane); continue; } r -= I_IN;
            if (r < I_OUT) { p0_transpose_item(a.in[7], DM, DM, WOUT, 0, scr, r, lane); continue; } r -= I_OUT;
            if (r < I_G) { p0_transpose_item(a.in[14], DM, DFF, WGU, 1, scr, r, lane); continue; } r -= I_G;
            if (r < I_G) { p0_transpose_item(a.in[15], DM, DFF, WGU, 2, scr, r, lane); continue; } r -= I_G;
            p0_transpose_item(a.in[16], DFF, DM, WDN, 0, scr, r, lane);
        }
        const float* rb = a.in[17];
        for (int idx = bx * 512 + tid; idx < 8 * 8192; idx += G * 512) { const int hh = idx >> 13, rel = (idx & 8191) - 4095; TBB[idx] = rb[rel_bucket(rel) * 16 + 8 + hh] * LOG2E; }
        for (int idx = bx * 512 + tid; idx < 3 * 8 * 132; idx += G * 512) { const int br = idx / (8 * 132), hh = (idx / 132) % 8, j = idx % 132, d = 16 >> (2 * br);
            TBA[idx] = (j == 0 || j >= 130) ? -__builtin_inff() : rb[rel_bucket(d * (j - 65)) * 16 + hh] * LOG2E; }
        for (int idx = bx * 512 + tid; idx < 3 * MT; idx += G * 512) SS[idx] = 0.f;
        for (int m = gw; m < MT; m += NGW) prenorm_row(xrow_ptr(a.in[0], a.in[1], m), a.in[2], H + (size_t)m * DM, lane);
    }
    SEAM(0);
    if (IN(1)) {
        pg8::Gemm g{H, WIN, MT, PW, DM}; pg8::StaticOrder S; S.init(MT, PW, G, bx);
        pg8::EpiBf16S E{PROJ, PW, Q_SCALE_A, Q_SCALE_B};
        pg8::gemm_phase<pg8::EpiBf16S, pg8::StaticOrder, true, true>(lds, g, S, E);
    }
    SEAM(1);
    if (IN(2)) {
        bf16* PO = Y; float* PML = (float*)(ws + WS_Y + 128 * MiB);
        mixa::phase<0>(lds, PROJ, MIXED, TBA, a.in[8], PO, PML, G, vcu);
        if (PH_MASK & 0x200) {
            const float s1 = a.in[9][lane] * a.in[10][lane], s2 = a.in[11][lane] * a.in[12][lane];
            const float lam = __expf(wave_sum(s1)) - __expf(wave_sum(s2)) + 0.2f;
            mixb::phase(lds, PROJ, MIXED, TBB, a.in[13], lam, G, vcu);
        }
        if (hi - lo > 1) xcd_barrier(bar);
        mixa::phase<1>(lds, PROJ, MIXED, TBA, a.in[8], PO, PML, G, vcu);
    }
    SEAM(2);
    if (IN(3)) {
        pg8::Gemm g{MIXED, WOUT, MT, DM, DM};
#if FUSED_NORM
        if (G == 256) {
            pg8::PanelOrder S{bx, 8};
            pg8::EpiNormResNorm E{a.in[0], a.in[1], Y, H, a.in[3], a.in[4], SS, SS + MT, PCNT, PCNT + 256 * 64};
            pg8::gemm_phase<pg8::EpiNormResNorm, pg8::PanelOrder, true, true>(lds, g, S, E);
        }
#else
        pg8::StaticOrder S; S.init(MT, DM, G, bx);
        pg8::EpiBf16S E{Y, DM, 1.f, 1.f};
        pg8::gemm_phase<pg8::EpiBf16S, pg8::StaticOrder, true, true>(lds, g, S, E);
#endif
    }
    SEAM(3);
    if (IN(4) && !FUSED_NORM) {
        for (int m = gw; m < MT; m += NGW) p4_row(xrow_ptr(a.in[0], a.in[1], m), Y + (size_t)m * DM, a.in[3], a.in[4], a.out + (size_t)m * DM, H + (size_t)m * DM, lane);
    }
    if (!FUSED_NORM) SEAM(4);
    if (IN(5)) {
        pg8::Gemm g{H, WGU, MT, 2 * DFF, DM}; pg8::StaticOrder S; S.init(MT, 2 * DFF, G, bx);
        pg8::EpiSwiGLU E{F, DFF};
        pg8::gemm_phase<pg8::EpiSwiGLU, pg8::StaticOrder, true, true>(lds, g, S, E);
#if PROBE_DUP & 4
        pg8::gemm_phase<pg8::EpiSwiGLU, pg8::StaticOrder, true, true>(lds, g, S, E);
#endif
    }
    SEAM(5);
    if (IN(6)) {
        pg8::Gemm g{F, WDN, MT, DM, DFF};
#if FUSED_NORM
        if (G == 256) {
            pg8::PanelOrder S{bx, 8};
            pg8::EpiNormResOut E{a.out, Y, a.in[5], SS + 2 * MT, PCNT + 512 * 64};
            pg8::gemm_phase<pg8::EpiNormResOut, pg8::PanelOrder, true, true>(lds, g, S, E);
        }
#else
        pg8::StaticOrder S; S.init(MT, DM, G, bx);
        pg8::EpiBf16S E{Y, DM, 1.f, 1.f};
        pg8::gemm_phase<pg8::EpiBf16S, pg8::StaticOrder, true, true>(lds, g, S, E);
#endif
    }
    if (!FUSED_NORM) SEAM(6);
    if (IN(7) && !FUSED_NORM) {
        for (int m = gw; m < MT; m += NGW) p7_row(Y + (size_t)m * DM, a.in[5], a.out + (size_t)m * DM, lane);
    }
#undef IN
#undef SEAM
}

#ifndef MK_ONE_LAUNCH
#define MK_ONE_LAUNCH 1
#endif
extern "C" void kernel_launch(void* const* d_in, const int* in_sizes, int n_in, void* d_out, int out_size, void* d_ws, size_t ws_size, hipStream_t stream) {
    static int grid = 0;
    if (grid == 0) {
        if (n_in != 18 || out_size != MT * DM || ws_size < WS_END) { fprintf(stderr, "kernel_launch: unexpected shapes (n_in %d, out %d, ws %zu)\n", n_in, out_size, ws_size); grid = -1; return; }
        int dev = 0, cus = 0, per_cu = 0;
        if (hipGetDevice(&dev) != hipSuccess || hipDeviceGetAttribute(&cus, hipDeviceAttributeMultiprocessorCount, dev) != hipSuccess) { grid = -1; return; }
        if (hipFuncSetAttribute((const void*)fwd_mega, hipFuncAttributeMaxDynamicSharedMemorySize, LDS_BYTES) != hipSuccess) { fprintf(stderr, "kernel_launch: hipFuncSetAttribute failed\n"); grid = -1; return; }
        if (hipOccupancyMaxActiveBlocksPerMultiprocessor(&per_cu, (const void*)fwd_mega, 512, LDS_BYTES) != hipSuccess || per_cu < 1) { fprintf(stderr, "kernel_launch: occupancy query says %d blocks per CU\n", per_cu); per_cu = 1; }
        (void)hipGetLastError();
        grid = cus * 1;
    }
    if (grid < 0) return;
    if (hipMemsetAsync((char*)d_ws + WS_CTL, 0, 262144, stream) != hipSuccess) { fprintf(stderr, "kernel_launch: memset of the barrier words failed\n"); return; }
    Args a{};
    for (int i = 0; i < 18; ++i) a.in[i] = (const float*)d_in[i];
    a.out = (float*)d_out; a.ws = (unsigned char*)d_ws;
#if MK_ONE_LAUNCH
    a.ph_lo = 0; a.ph_hi = N_PHASES;
    void* args[] = {&a};
    hipError_t e = hipLaunchCooperativeKernel((const void*)fwd_mega, dim3(grid), dim3(512), args, LDS_BYTES, stream);
    if (e != hipSuccess) fprintf(stderr, "kernel_launch: cooperative launch failed: %s (grid %d)\n", hipGetErrorString(e), grid);
#else
    for (int p = 0; p < N_PHASES; ++p) { a.ph_lo = p; a.ph_hi = p + 1; hipLaunchKernelGGL(fwd_mega, dim3(grid), dim3(512), LDS_BYTES, stream, a); }
#endif
}
```

```cpp
#include <hip/hip_runtime.h>
#include <hip/hip_cooperative_groups.h>
#include <cstdio>
#include <cstdint>
namespace cg = cooperative_groups;

namespace pg8 {
#define PG8_LAS __attribute__((address_space(3)))
typedef unsigned short bf16_t;
typedef short bf16x8 __attribute__((ext_vector_type(8)));
typedef float f32x4 __attribute__((ext_vector_type(4)));
typedef unsigned u32x4 __attribute__((ext_vector_type(4)));
constexpr int BM = 256, BK = 64, HALF = 128, HTB = HALF * BK * 2  , STAGE_BYTES = 8 * HTB, NXCD = 8, WGM = 8;

__host__ __device__ __forceinline__ int lds_byte(int r, int c) { const int st = (r >> 4) * 2 + (c >> 5), rr = r & 15, cc = c & 31, ob = rr * 64 + cc * 2; return st * 1024 + (ob ^ (((ob >> 9) & 1) << 5)); }
__host__ __device__ __forceinline__ void stage_rc(int b, int& R, int& C) { const int st = b / 1024, sb = b % 1024, swz = sb ^ (((sb >> 9) & 1) << 5); R = (st >> 1) * 16 + swz / 64; C = (st & 1) * 32 + (swz % 64) / 2; }
__host__ __device__ __forceinline__ int perm32(int rho) { const int n = rho >> 4, i = rho & 15; return 8 * (i >> 2) + 4 * n + (i & 3); }

struct Unit { int pm, pn; };
struct Gemm { const bf16_t* A; const bf16_t* Bt; int M, N, K; };

struct StaticOrder {
    int nM, nN, nwg, G, c;
    __host__ __device__ void init(int M, int N, int G_, int c_) { nM = M / BM; nN = N / BM; nwg = nM * nN; G = G_; c = c_; }
    __host__ __device__ bool next(int i, Unit& u) const {
        const long L = (long)i * G + c; if (L >= nwg) return false;
        int wgid = (int)L; { const int q = nwg / NXCD, r = nwg % NXCD, xcd = wgid % NXCD, off = wgid / NXCD; wgid = (xcd < r ? xcd * (q + 1) : r * (q + 1) + (xcd - r) * q) + off; }
        const int nig = WGM * nN, gid = wgid / nig, fm = gid * WGM, gsz = (nM - fm) < WGM ? (nM - fm) : WGM;
        u.pm = fm + ((wgid % nig) % gsz); u.pn = (wgid % nig) / gsz; return true;
    }
    __device__ __forceinline__ void a_ready(const Unit&) const {}
    __device__ __forceinline__ void done(const Unit&) const {}
};
__device__ __forceinline__ unsigned cvt_pk_bf16(float lo, float hi) { unsigned r; asm volatile("v_cvt_pk_bf16_f32 %0, %1, %2" : "=v"(r) : "v"(lo), "v"(hi)); return r; }
typedef float f32x2 __attribute__((ext_vector_type(2)));
struct EpiBf16S {
    static constexpr bool PERM = true, AFTER_DRAIN = false;
    bf16_t* O; int ldc; float sA, sB;
    __device__ __forceinline__ void operator()(const f32x4 (&acc)[2][2][4][2], const Unit& u, int wr, int wc, int fr, int fq) const {
        const int row0 = u.pm * BM + wr * 64 + fr, col0 = u.pn * BM + wc * 32 + 8 * fq;
        const float sc = (u.pn < 4) ? sA : ((u.pn >= 12 && u.pn < 16) ? sB : 1.f);
#pragma unroll
        for (int ai = 0; ai < 2; ++ai)
#pragma unroll
            for (int m = 0; m < 4; ++m) { bf16_t* rowp = O + (size_t)(row0 + ai * HALF + m * 16) * ldc + col0;
#pragma unroll
                for (int bj = 0; bj < 2; ++bj) { const f32x4 v0 = acc[ai][bj][m][0] * sc, v1 = acc[ai][bj][m][1] * sc;
                    u32x4 w; w.x = cvt_pk_bf16(v0[0], v0[1]); w.y = cvt_pk_bf16(v0[2], v0[3]); w.z = cvt_pk_bf16(v1[0], v1[1]); w.w = cvt_pk_bf16(v1[2], v1[3]);
                    *(u32x4*)(rowp + bj * HALF) = w; } }
    }
};
__device__ __forceinline__ float silu_mul(float g, float u) { return g * u * __builtin_amdgcn_rcpf(1.f + __builtin_amdgcn_exp2f(-1.4426950408889634f * g)); }
struct EpiSwiGLU {
    static constexpr bool PERM = true, AFTER_DRAIN = false;
    bf16_t* O; int ldc;
    __device__ __forceinline__ void operator()(const f32x4 (&acc)[2][2][4][2], const Unit& u, int wr, int wc, int fr, int fq) const {
        const int row0 = u.pm * BM + wr * 64 + fr, col0 = u.pn * HALF + wc * 32 + 8 * fq;
#pragma unroll
        for (int ai = 0; ai < 2; ++ai)
#pragma unroll
            for (int m = 0; m < 4; ++m) { bf16_t* rowp = O + (size_t)(row0 + ai * HALF + m * 16) * ldc + col0;
                const f32x4 g0 = acc[ai][0][m][0], g1 = acc[ai][0][m][1], u0 = acc[ai][1][m][0], u1 = acc[ai][1][m][1];
                u32x4 w; w.x = cvt_pk_bf16(silu_mul(g0[0], u0[0]), silu_mul(g0[1], u0[1])); w.y = cvt_pk_bf16(silu_mul(g0[2], u0[2]), silu_mul(g0[3], u0[3]));
                w.z = cvt_pk_bf16(silu_mul(g1[0], u1[0]), silu_mul(g1[1], u1[1])); w.w = cvt_pk_bf16(silu_mul(g1[2], u1[2]), silu_mul(g1[3], u1[3]));
                *(u32x4*)rowp = w; }
    }
};

struct PanelOrder {
    int c, nrounds;
    __device__ __forceinline__ bool next(int i, Unit& u) const { if (i >= nrounds) return false; const int x = c & 7, j = c >> 3; u.pm = 32 * i + 4 * x + (j >> 3); u.pn = j & 7; return true; }
    __device__ __forceinline__ void a_ready(const Unit&) const {}
    __device__ __forceinline__ void done(const Unit&) const {}
};
__device__ __forceinline__ void panel_sync(unsigned* cnt) {
    asm volatile("s_waitcnt vmcnt(0)" ::: "memory");
    __builtin_amdgcn_s_barrier();
    if (threadIdx.x == 0) {
        __hip_atomic_fetch_add(cnt, 1u, __ATOMIC_RELAXED, __HIP_MEMORY_SCOPE_AGENT);
        unsigned spins = 0;
        while (__hip_atomic_load(cnt, __ATOMIC_RELAXED, __HIP_MEMORY_SCOPE_AGENT) < 8u && ++spins < (1u << 24)) __builtin_amdgcn_s_sleep(1);
    }
    asm volatile("" ::: "memory");
    __builtin_amdgcn_s_barrier();
    asm volatile("" ::: "memory");
}
__device__ __forceinline__ float ld_sc1(const float* p) { return __hip_atomic_load(p, __ATOMIC_RELAXED, __HIP_MEMORY_SCOPE_AGENT); }
__device__ __forceinline__ float quad_row_sum(float s) { s += __shfl_xor(s, 16); s += __shfl_xor(s, 32); return s; }
__device__ __forceinline__ float dot4(f32x4 v) { return (v[0] * v[0] + v[1] * v[1]) + (v[2] * v[2] + v[3] * v[3]); }
struct EpiNormResNorm {
    static constexpr bool PERM = true, AFTER_DRAIN = false;
    const float* xp; const float* xs; bf16_t* X1; bf16_t* Hn; const float* g1; const float* g2; float* ss1; float* ss2; unsigned* cnt1; unsigned* cnt2;
    __device__ __forceinline__ void operator()(f32x4 (&acc)[2][2][4][2], const Unit& u, int wr, int wc, int fr, int fq) const {
        const int row0 = u.pm * BM + wr * 64 + fr, col0 = u.pn * BM + wc * 32 + 8 * fq;
#pragma unroll
        for (int ai = 0; ai < 2; ++ai)
#pragma unroll
            for (int m = 0; m < 4; ++m) { float s = 0.f;
#pragma unroll
                for (int bj = 0; bj < 2; ++bj) s += dot4(acc[ai][bj][m][0]) + dot4(acc[ai][bj][m][1]);
                s = quad_row_sum(s);
                if (fq == 0) __hip_atomic_fetch_add(ss1 + row0 + ai * HALF + m * 16, s, __ATOMIC_RELAXED, __HIP_MEMORY_SCOPE_AGENT); }
        panel_sync(cnt1 + 64 * u.pm);
        f32x4 gv[2][2];
#pragma unroll
        for (int bj = 0; bj < 2; ++bj) { gv[bj][0] = *(const f32x4*)(g1 + col0 + bj * HALF); gv[bj][1] = *(const f32x4*)(g1 + col0 + bj * HALF + 4); }
#pragma unroll
        for (int ai = 0; ai < 2; ++ai)
#pragma unroll
            for (int m = 0; m < 4; ++m) { const int row = row0 + ai * HALF + m * 16;
                const float r1 = 1.f / sqrtf(ld_sc1(ss1 + row) * (1.f / 2048.f) + 1e-6f);
                const float* xrow = (row < 32768 ? xp + (size_t)row * 2048 : xs + (size_t)(row - 32768) * 2048) + col0;
                bf16_t* orow = X1 + (size_t)row * 2048 + col0; float s = 0.f;
#pragma unroll
                for (int bj = 0; bj < 2; ++bj) { const f32x4 x0 = *(const f32x4*)(xrow + bj * HALF), x1 = *(const f32x4*)(xrow + bj * HALF + 4);
                    const f32x4 v0 = x0 + acc[ai][bj][m][0] * r1 * gv[bj][0], v1 = x1 + acc[ai][bj][m][1] * r1 * gv[bj][1];
                    acc[ai][bj][m][0] = v0; acc[ai][bj][m][1] = v1; s += dot4(v0) + dot4(v1);
                    u32x4 w; w.x = cvt_pk_bf16(v0[0], v0[1]); w.y = cvt_pk_bf16(v0[2], v0[3]); w.z = cvt_pk_bf16(v1[0], v1[1]); w.w = cvt_pk_bf16(v1[2], v1[3]); *(u32x4*)(orow + bj * HALF) = w; }
                s = quad_row_sum(s);
                if (fq == 0) __hip_atomic_fetch_add(ss2 + row, s, __ATOMIC_RELAXED, __HIP_MEMORY_SCOPE_AGENT); }
        panel_sync(cnt2 + 64 * u.pm);
#pragma unroll
        for (int bj = 0; bj < 2; ++bj) { gv[bj][0] = *(const f32x4*)(g2 + col0 + bj * HALF); gv[bj][1] = *(const f32x4*)(g2 + col0 + bj * HALF + 4); }
#pragma unroll
        for (int ai = 0; ai < 2; ++ai)
#pragma unroll
            for (int m = 0; m < 4; ++m) { const int row = row0 + ai * HALF + m * 16;
                const float r2 = 1.f / sqrtf(ld_sc1(ss2 + row) * (1.f / 2048.f) + 1e-6f);
                bf16_t* hrow = Hn + (size_t)row * 2048 + col0;
#pragma unroll
                for (int bj = 0; bj < 2; ++bj) { const f32x4 v0 = acc[ai][bj][m][0] * r2 * gv[bj][0], v1 = acc[ai][bj][m][1] * r2 * gv[bj][1];
                    u32x4 w; w.x = cvt_pk_bf16(v0[0], v0[1]); w.y = cvt_pk_bf16(v0[2], v0[3]); w.z = cvt_pk_bf16(v1[0], v1[1]); w.w = cvt_pk_bf16(v1[2], v1[3]);
                    *(u32x4*)(hrow + bj * HALF) = w; } }
    }
};
struct EpiNormResOut {
    static constexpr bool PERM = true, AFTER_DRAIN = false;
    float* OUT; const bf16_t* X1; const float* g; float* ss; unsigned* cnt;
    __device__ __forceinline__ void operator()(f32x4 (&acc)[2][2][4][2], const Unit& u, int wr, int wc, int fr, int fq) const {
        const int row0 = u.pm * BM + wr * 64 + fr, col0 = u.pn * BM + wc * 32 + 8 * fq;
#pragma unroll
        for (int ai = 0; ai < 2; ++ai)
#pragma unroll
            for (int m = 0; m < 4; ++m) { float s = 0.f;
#pragma unroll
                for (int bj = 0; bj < 2; ++bj) s += dot4(acc[ai][bj][m][0]) + dot4(acc[ai][bj][m][1]);
                s = quad_row_sum(s);
                if (fq == 0) __hip_atomic_fetch_add(ss + row0 + ai * HALF + m * 16, s, __ATOMIC_RELAXED, __HIP_MEMORY_SCOPE_AGENT); }
        panel_sync(cnt + 64 * u.pm);
        f32x4 gv[2][2];
#pragma unroll
        for (int bj = 0; bj < 2; ++bj) { gv[bj][0] = *(const f32x4*)(g + col0 + bj * HALF); gv[bj][1] = *(const f32x4*)(g + col0 + bj * HALF + 4); }
#pragma unroll
        for (int ai = 0; ai < 2; ++ai)
#pragma unroll
            for (int m = 0; m < 4; ++m) { const int row = row0 + ai * HALF + m * 16;
                const float r1 = 1.f / sqrtf(ld_sc1(ss + row) * (1.f / 2048.f) + 1e-6f);
                float* orow = OUT + (size_t)row * 2048 + col0;
#pragma unroll
                for (int bj = 0; bj < 2; ++bj) { const u32x4 w = *(const u32x4*)(X1 + (size_t)row * 2048 + col0 + bj * HALF);
                    const f32x4 x0 = {__builtin_bit_cast(float, w.x << 16), __builtin_bit_cast(float, w.x & 0xffff0000u), __builtin_bit_cast(float, w.y << 16), __builtin_bit_cast(float, w.y & 0xffff0000u)};
                    const f32x4 x1 = {__builtin_bit_cast(float, w.z << 16), __builtin_bit_cast(float, w.z & 0xffff0000u), __builtin_bit_cast(float, w.w << 16), __builtin_bit_cast(float, w.w & 0xffff0000u)};
                    *(f32x4*)(orow + bj * HALF) = x0 + acc[ai][bj][m][0] * r1 * gv[bj][0]; *(f32x4*)(orow + bj * HALF + 4) = x1 + acc[ai][bj][m][1] * r1 * gv[bj][1]; } }
    }
};

template <class Epi, class Sched, bool ALIGN_EPI = false, bool SP2 = false>
__device__ __forceinline__ void gemm_phase(PG8_LAS unsigned char* lds, const Gemm g, const Sched& S, const Epi& E) {
    const int tid = threadIdx.x, wid = __builtin_amdgcn_readfirstlane(tid >> 6), lane = tid & 63, wr = wid >> 2, wc = wid & 3, fr = lane & 15, fq = lane >> 4;
    const int K = g.K, nt = K / BK;
    unsigned voffA[2], voffB[2];
#pragma unroll
    for (int i = 0; i < 2; ++i) { int R, C; stage_rc(tid * 16 + i * 8192, R, C); const int Rb = Epi::PERM ? ((R & ~31) + perm32(R & 31)) : R;
        voffA[i] = (unsigned)(R * K + C) * 2u; voffB[i] = (unsigned)(Rb * K + C) * 2u; }
    const size_t kstep = (size_t)(BK * 2);
    const size_t hstep = (size_t)HALF * K * 2;
    const size_t tstep = 2 * hstep;
    const unsigned ldsw = (unsigned)wid * 1024u;
    const int aoff = lds_byte(wr * 64 + fr, fq * 8), boff = lds_byte(wc * 32 + fr, fq * 8);
#define PG8_SA(b, h) (((b) * 2 + (h)) * HTB)
#define PG8_SB(b, h) ((4 + (b) * 2 + (h)) * HTB)
#define PG8_STAGE(bufoff, gbase, voff) do { _Pragma("unroll") for (int _i = 0; _i < 2; ++_i) \
        __builtin_amdgcn_global_load_lds((const unsigned*)((const char*)(gbase) + (voff)[_i]), (PG8_LAS unsigned*)(lds + (bufoff) + ldsw + _i * 8192), 16, 0, 0); } while (0)
#define PG8_LDA(dst, b, h) do { _Pragma("unroll") for (int m = 0; m < 4; ++m) _Pragma("unroll") for (int k = 0; k < 2; ++k) dst[m][k] = *(const PG8_LAS bf16x8*)(lds + PG8_SA(b, h) + aoff + m * 2048 + k * 1024); } while (0)
#define PG8_LDB(dst, b, h) do { _Pragma("unroll") for (int n = 0; n < 2; ++n) _Pragma("unroll") for (int k = 0; k < 2; ++k) dst[n][k] = *(const PG8_LAS bf16x8*)(lds + PG8_SB(b, h) + boff + n * 2048 + k * 1024); } while (0)
#define PG8_MMA(ai, bj, At, Bt) do { __builtin_amdgcn_s_setprio(1); _Pragma("unroll") for (int m = 0; m < 4; ++m) _Pragma("unroll") for (int n = 0; n < 2; ++n) _Pragma("unroll") for (int k = 0; k < 2; ++k) \
        acc[ai][bj][m][n] = __builtin_amdgcn_mfma_f32_16x16x32_bf16(Bt[n][k], At[m][k], acc[ai][bj][m][n], 0, 0, 0); __builtin_amdgcn_s_setprio(0); } while (0)
#define PG8_WAIT_V(n) asm volatile("s_waitcnt vmcnt(" #n ")" ::: "memory")
#define PG8_WAIT_L(n) asm volatile("s_waitcnt lgkmcnt(" #n ")" ::: "memory")
#define PG8_BAR __builtin_amdgcn_s_barrier()
#define PG8_SCHED __builtin_amdgcn_sched_barrier(0)
    Unit cur, nxt; int ui = 0;
    if (!S.next(0, cur)) return;
    f32x4 acc[2][2][4][2];
#pragma unroll
    for (int a = 0; a < 2; ++a)
#pragma unroll
        for (int b = 0; b < 2; ++b)
#pragma unroll
            for (int m = 0; m < 4; ++m)
#pragma unroll
                for (int n = 0; n < 2; ++n) acc[a][b][m][n] = (f32x4){0.f, 0.f, 0.f, 0.f};
    bf16x8 At[4][2], B0[2][2], B1[2][2];
    const char* cA = (const char*)g.A + (size_t)cur.pm * tstep; const char* cB = (const char*)g.Bt + (size_t)cur.pn * tstep;
    S.a_ready(cur);
    if constexpr (SP2) {
        PG8_STAGE(PG8_SB(0, 0), cB, voffB); PG8_STAGE(PG8_SB(0, 1), cB + hstep, voffB); PG8_STAGE(PG8_SA(0, 0), cA, voffA); PG8_STAGE(PG8_SA(0, 1), cA + hstep, voffA);
        if (wr == 1) PG8_BAR;
        PG8_WAIT_V(2); PG8_BAR;
        PG8_STAGE(PG8_SB(1, 0), cB + kstep, voffB); PG8_STAGE(PG8_SA(1, 0), cA + kstep, voffA); PG8_STAGE(PG8_SB(1, 1), cB + hstep + kstep, voffB);
        PG8_WAIT_V(6); PG8_BAR;
    } else {
        PG8_STAGE(PG8_SB(0, 0), cB, voffB); PG8_STAGE(PG8_SA(0, 0), cA, voffA); PG8_STAGE(PG8_SB(0, 1), cB + hstep, voffB); PG8_STAGE(PG8_SA(0, 1), cA + hstep, voffA);
        if (wr == 1) PG8_BAR;
        PG8_WAIT_V(4); PG8_BAR;
        PG8_STAGE(PG8_SB(1, 0), cB + kstep, voffB); PG8_STAGE(PG8_SA(1, 0), cA + kstep, voffA); PG8_STAGE(PG8_SB(1, 1), cB + hstep + kstep, voffB);
        PG8_WAIT_V(6); PG8_BAR;
    }
    for (;;) {
        const bool has_next = S.next(ui + 1, nxt);
        const char* nA = has_next ? (const char*)g.A + (size_t)nxt.pm * tstep : cA; const char* nB = has_next ? (const char*)g.Bt + (size_t)nxt.pn * tstep : cB;
        for (int t = 0; t < nt; t += 2) {
            const bool last = (t == nt - 2);
            const char* a1 = cA + (size_t)(t + 1) * kstep;
            const char* a2 = last ? nA : cA + (size_t)(t + 2) * kstep; const char* b2 = last ? nB : cB + (size_t)(t + 2) * kstep;
            const char* a3 = a2 + kstep; const char* b3 = b2 + kstep;
            if (last && has_next) S.a_ready(nxt);
            if constexpr (SP2) {
            PG8_LDB(B0, 0, 0); PG8_LDB(B1, 0, 1); PG8_SCHED; PG8_LDA(At, 0, 0); PG8_STAGE(PG8_SA(1, 1), a1 + hstep, voffA);
            PG8_WAIT_V(8); PG8_WAIT_L(0); PG8_BAR; PG8_MMA(0, 0, At, B0); PG8_MMA(0, 1, At, B1); PG8_BAR; PG8_SCHED;
            PG8_LDA(At, 0, 1); PG8_STAGE(PG8_SB(0, 0), b2, voffB); PG8_STAGE(PG8_SB(0, 1), b2 + hstep, voffB); PG8_STAGE(PG8_SA(0, 0), a2, voffA);
            PG8_WAIT_V(8); PG8_WAIT_L(0); PG8_BAR; PG8_MMA(1, 0, At, B0); PG8_MMA(1, 1, At, B1); PG8_BAR; PG8_SCHED;
            PG8_LDB(B0, 1, 0); PG8_LDB(B1, 1, 1); PG8_SCHED; PG8_LDA(At, 1, 0); PG8_STAGE(PG8_SA(0, 1), a2 + hstep, voffA);
            PG8_WAIT_V(8); PG8_WAIT_L(0); PG8_BAR; PG8_MMA(0, 0, At, B0); PG8_MMA(0, 1, At, B1); PG8_BAR; PG8_SCHED;
            PG8_LDA(At, 1, 1); PG8_STAGE(PG8_SB(1, 0), b3, voffB); PG8_STAGE(PG8_SB(1, 1), b3 + hstep, voffB); PG8_STAGE(PG8_SA(1, 0), a3, voffA);
            PG8_WAIT_V(8); PG8_WAIT_L(0); PG8_BAR; PG8_MMA(1, 0, At, B0); PG8_MMA(1, 1, At, B1); PG8_BAR; PG8_SCHED;
            } else {
            PG8_LDB(B0, 0, 0); PG8_SCHED; PG8_LDA(At, 0, 0); PG8_STAGE(PG8_SA(1, 1), a1 + hstep, voffA);
            PG8_WAIT_L(8); PG8_BAR; PG8_WAIT_L(0); PG8_MMA(0, 0, At, B0); PG8_BAR; PG8_SCHED;
            PG8_LDB(B1, 0, 1); PG8_STAGE(PG8_SB(0, 0), b2, voffB);
            PG8_BAR; PG8_WAIT_L(0); PG8_MMA(0, 1, At, B1); PG8_BAR;
            PG8_LDA(At, 0, 1); PG8_STAGE(PG8_SA(0, 0), a2, voffA);
            PG8_BAR; PG8_WAIT_L(0); PG8_MMA(1, 0, At, B0); PG8_BAR; PG8_SCHED;
            PG8_STAGE(PG8_SB(0, 1), b2 + hstep, voffB);
            PG8_WAIT_V(6); PG8_BAR; PG8_MMA(1, 1, At, B1); PG8_BAR;
            PG8_LDB(B0, 1, 0); PG8_SCHED; PG8_LDA(At, 1, 0); PG8_STAGE(PG8_SA(0, 1), a2 + hstep, voffA);
            PG8_WAIT_L(8); PG8_BAR; PG8_WAIT_L(0); PG8_MMA(0, 0, At, B0); PG8_BAR; PG8_SCHED;
            PG8_LDB(B1, 1, 1); PG8_STAGE(PG8_SB(1, 0), b3, voffB);
            PG8_BAR; PG8_WAIT_L(0); PG8_MMA(0, 1, At, B1); PG8_BAR;
            PG8_LDA(At, 1, 1); PG8_STAGE(PG8_SA(1, 0), a3, voffA);
            PG8_BAR; PG8_WAIT_L(0); PG8_MMA(1, 0, At, B0); PG8_BAR; PG8_SCHED;
            PG8_STAGE(PG8_SB(1, 1), b3 + hstep, voffB);
            PG8_WAIT_V(6); PG8_BAR; PG8_MMA(1, 1, At, B1); PG8_BAR;
            }
        }
        if constexpr (ALIGN_EPI) { if (wr == 0) PG8_BAR; }
        if constexpr (!Epi::AFTER_DRAIN) { E(acc, cur, wr, wc, fr, fq); S.done(cur); }
        if (!has_next) break;
#pragma unroll
        for (int a = 0; a < 2; ++a)
#pragma unroll
            for (int b = 0; b < 2; ++b)
#pragma unroll
                for (int m = 0; m < 4; ++m)
#pragma unroll
                    for (int n = 0; n < 2; ++n) acc[a][b][m][n] = (f32x4){0.f, 0.f, 0.f, 0.f};
        cur = nxt; cA = nA; cB = nB; ++ui;
        if constexpr (ALIGN_EPI) { if (wr == 1) PG8_BAR; }
    }
    PG8_WAIT_V(0);
    if constexpr (!ALIGN_EPI) { if (wr == 0) PG8_BAR; }
    PG8_BAR;
    if constexpr (Epi::AFTER_DRAIN) { E.fused(acc, cur, wr, wc, fr, fq, lds, wid, lane); S.done(cur); }
#undef PG8_SA
#undef PG8_SB
#undef PG8_STAGE
#undef PG8_LDA
#undef PG8_LDB
#undef PG8_MMA
#undef PG8_WAIT_V
#undef PG8_WAIT_L
#undef PG8_BAR
#undef PG8_SCHED
}
}

#ifndef FUSED_NORM
#define FUSED_NORM 1
#endif
#ifndef PROBE_DUP
#define PROBE_DUP 0
#endif

constexpr int DM = 2048, PW = 6144, DFF = 5632, MT = 65536, M_P = 32768, S_P = 4096, S_S = 2048;
constexpr float EPS = 1e-6f, LOG2E = 1.4426950408889634f;
constexpr float Q_SCALE_A = 0.08838834764831845f * LOG2E, Q_SCALE_B = 0.125f * LOG2E;
constexpr size_t MiB = 1u << 20;
constexpr size_t WS_WIN = 0, WS_WOUT = 24 * MiB, WS_WGU = 32 * MiB, WS_WDN = 76 * MiB;
constexpr size_t WS_TBB = 98 * MiB, WS_TBA = 98 * MiB + 512 * 1024;
constexpr size_t WS_H = 100 * MiB, WS_PROJ = 356 * MiB, WS_MIXED = 1124 * MiB, WS_Y = 1380 * MiB, WS_CTL = 1636 * MiB, WS_SS = 1636 * MiB + 256 * 1024, WS_END = 1637 * MiB;
constexpr int LDS_BYTES = 155648, BAR_LDS_OFF = 151552;

#define LAS __attribute__((address_space(3)))
typedef unsigned short bf16;
typedef short bf16x8 __attribute__((ext_vector_type(8)));
typedef short s16x4 __attribute__((ext_vector_type(4)));
typedef float f32x4 __attribute__((ext_vector_type(4)));
typedef float f32x16 __attribute__((ext_vector_type(16)));
typedef unsigned u32x4 __attribute__((ext_vector_type(4)));
typedef unsigned u32x2 __attribute__((ext_vector_type(2)));
#define LDS_WAIT() asm volatile("s_waitcnt lgkmcnt(0)" ::: "memory")
#define SBAR() __builtin_amdgcn_sched_barrier(0)
__device__ __forceinline__ unsigned cvtpk(float lo, float hi) { unsigned r; asm volatile("v_cvt_pk_bf16_f32 %0, %1, %2" : "=v"(r) : "v"(lo), "v"(hi)); return r; }
__device__ __forceinline__ unsigned f2bf(float f) { unsigned u = __builtin_bit_cast(unsigned, f); return (u + 0x7fffu + ((u >> 16) & 1u)) >> 16; }
__device__ __forceinline__ float bflo(unsigned w) { return __builtin_bit_cast(float, w << 16); }
__device__ __forceinline__ float bfhi(unsigned w) { return __builtin_bit_cast(float, w & 0xffff0000u); }
__device__ __forceinline__ float wave_sum(float v) {
#pragma unroll
    for (int o = 1; o < 64; o <<= 1) v += __shfl_xor(v, o);
    return v;
}
__device__ __forceinline__ int crow(int r, int hi) { return (r & 3) + 8 * (r >> 2) + 4 * hi; }
__device__ __forceinline__ int v_st(int k, int c) { const int kk = (k & ~0xC) | ((k & 4) << 1) | ((k & 8) >> 1); return ((kk >> 3) * 4 + (c >> 5)) * 512 + ((kk & 7) * 32 + (c & 31)) * 2; }
__device__ __forceinline__ int v_rd_base(int lane) { return ((lane & 3) << 3) | (((lane >> 2) & 3) << 6) | (((lane >> 4) & 1) << 5) | (((lane >> 5) & 1) << 8); }
constexpr int v_rd_off(int d0, int ks, int half) { return d0 * 512 + ks * 4096 + half * 2048; }
template <int OFF> __device__ __forceinline__ s16x4 tr_read(int vb) { s16x4 r; asm volatile("ds_read_b64_tr_b16 %0, %1 offset:%2" : "=&v"(r) : "v"(vb), "i"(OFF) : "memory"); return r; }
#define PKV(L, H) (bf16x8){L[0], L[1], L[2], L[3], H[0], H[1], H[2], H[3]}
#define PK4(P, BASE, OUT) do { unsigned a0 = cvtpk(P[BASE + 0], P[BASE + 1]), a1 = cvtpk(P[BASE + 2], P[BASE + 3]);   \
    unsigned b0 = cvtpk(P[BASE + 4], P[BASE + 5]), b1 = cvtpk(P[BASE + 6], P[BASE + 7]);                              \
    auto r0 = __builtin_amdgcn_permlane32_swap(a0, b0, false, false); auto r1 = __builtin_amdgcn_permlane32_swap(a1, b1, false, false); \
    u32x4 w = {r0[0], r1[0], r0[1], r1[1]}; OUT = __builtin_bit_cast(bf16x8, w); } while (0)
__device__ __forceinline__ float half_max(float v) { auto rr = __builtin_amdgcn_permlane32_swap(__float_as_uint(v), __float_as_uint(v), false, false); return fmaxf(__uint_as_float(rr[0]), __uint_as_float(rr[1])); }
__device__ __forceinline__ float half_add(float v) { auto rr = __builtin_amdgcn_permlane32_swap(__float_as_uint(v), __float_as_uint(v), false, false); return __uint_as_float(rr[0]) + __uint_as_float(rr[1]); }

__device__ __forceinline__ int rel_bucket(int rel) {
    const int n = rel < 0 ? -rel : rel;
    int b = n;
    if (n >= 8) b = 8 + (n >= 15) + (n >= 27) + (n >= 50) + (n >= 91) + (n >= 166) + (n >= 305) + (n >= 559);
    return b + (rel > 0 ? 16 : 0);
}

__device__ __forceinline__ void p0_transpose_item(const float* W, int K, int N, bf16* WT, int mode, LAS float* scr, int item, int lane) {
    const int nblk = N / 32, kb = item / nblk, nb = item % nblk, k0 = 64 * kb, n0 = 32 * nb;
#pragma unroll 8
    for (int i = 0; i < 32; ++i) { const int kk = 2 * i + (lane >> 5); scr[kk * 33 + (lane & 31)] = W[(size_t)(k0 + kk) * N + n0 + (lane & 31)]; }
    LDS_WAIT();
    const int drow0 = mode == 0 ? n0 : (256 * (n0 >> 7) + (n0 & 127) + (mode == 2 ? 128 : 0));
    const int c = lane & 7;
#pragma unroll
    for (int j = 0; j < 4; ++j) { const int n = (lane >> 3) + 8 * j; const LAS float* s = scr + (8 * c) * 33 + n;
        u32x4 o; o.x = cvtpk(s[0 * 33], s[1 * 33]); o.y = cvtpk(s[2 * 33], s[3 * 33]); o.z = cvtpk(s[4 * 33], s[5 * 33]); o.w = cvtpk(s[6 * 33], s[7 * 33]);
        *(u32x4*)(WT + (size_t)(drow0 + n) * K + k0 + 8 * c) = o; }
    LDS_WAIT();
}
__device__ __forceinline__ const float* xrow_ptr(const float* xp, const float* xs, int m) { return m < M_P ? xp + (size_t)m * DM : xs + (size_t)(m - M_P) * DM; }
__device__ __forceinline__ void prenorm_row(const float* xrow, const float* g, bf16* orow, int lane) {
    const f32x4* xr = (const f32x4*)xrow + lane; f32x4 v[8]; float s = 0.f;
#pragma unroll
    for (int j = 0; j < 8; ++j) { v[j] = xr[64 * j]; s += (v[j].x * v[j].x + v[j].y * v[j].y) + (v[j].z * v[j].z + v[j].w * v[j].w); }
    const float r = 1.f / sqrtf(wave_sum(s) * (1.f / DM) + EPS);
    u32x2* o8 = (u32x2*)orow + lane;
#pragma unroll
    for (int j = 0; j < 8; ++j) { const f32x4 gv = ((const f32x4*)g)[lane + 64 * j]; u32x2 w; w.x = cvtpk(v[j].x * r * gv.x, v[j].y * r * gv.y); w.y = cvtpk(v[j].z * r * gv.z, v[j].w * r * gv.w); o8[64 * j] = w; }
}

namespace mixa {
constexpr int KB_OFF = 65536, TBA_OFF = 131072, SSQ_OFF = 143872, LI_OFF = 145920;
template <int D0> __device__ __forceinline__ void pv_one(f32x16& od, int vb, bf16x8 pa0, bf16x8 pa1) {
    s16x4 l0 = tr_read<v_rd_off(D0, 0, 0)>(vb), h0 = tr_read<v_rd_off(D0, 0, 1)>(vb), l1 = tr_read<v_rd_off(D0, 1, 0)>(vb), h1 = tr_read<v_rd_off(D0, 1, 1)>(vb);
    asm volatile("s_waitcnt lgkmcnt(0)" : "+v"(l0), "+v"(h0), "+v"(l1), "+v"(h1) :: "memory");
    od = __builtin_amdgcn_mfma_f32_32x32x16_bf16(pa0, PKV(l0, h0), od, 0, 0, 0);
    od = __builtin_amdgcn_mfma_f32_32x32x16_bf16(pa1, PKV(l1, h1), od, 0, 0, 0);
}
template <int MODE>
__device__ __forceinline__ void phase(LAS unsigned char* lds, const bf16* __restrict__ PROJ, bf16* __restrict__ MIXED, const float* __restrict__ tbA_g, const float* __restrict__ norm_a_g, bf16* PO, float* PML, int G, int vcu) {
    constexpr int NT = MODE ? 13 : 5;
    const int tid = threadIdx.x, wid = __builtin_amdgcn_readfirstlane(tid >> 6), lane = tid & 63, r32 = lane & 31, hi = lane >> 5;
    const int h = wid;
    LAS float* tb = (LAS float*)(lds + TBA_OFF);
    for (int i = tid; i < 3 * 8 * 132; i += 512) tb[i] = tbA_g[i];
    __syncthreads();
    LAS unsigned char* vbuf = lds + wid * 8192;
    LAS unsigned char* kbuf = lds + KB_OFF + wid * 8192;
    const int vb0 = (int)(uintptr_t)vbuf + v_rd_base(lane);
    LAS float* ssq = (LAS float*)(lds + SSQ_OFF); LAS float* li_l = (LAS float*)(lds + LI_OFF) + wid * 64; LAS float* al_l = li_l + 32;
    const int vq = lane >> 4, vc = (lane & 15) * 8;
    const int vst_lane = (vc >> 5) * 512 + (vq * 32 + (vc & 31)) * 2;
    int par = 0;
    for (int unit = vcu; unit < 2048; unit += G, par ^= 1) {
        int r, R0, S, T0, Q0;
        if (MODE) { r = unit & 15; const int grp = unit >> 4; int blk;
            if (grp < 64) { R0 = (grp >> 3) * S_P; S = S_P; blk = grp & 7; } else { const int g2 = grp - 64; R0 = M_P + (g2 >> 2) * S_S; S = S_S; blk = g2 & 3; }
            T0 = 32 * blk; Q0 = 0; }
        else { r = 0; T0 = 0;
            if (unit < 1024) { R0 = (unit >> 7) * S_P; S = S_P; Q0 = 32 * (unit & 127); } else { const int u2 = unit - 1024; R0 = M_P + (u2 >> 6) * S_S; S = S_S; Q0 = 32 * (u2 & 63); } }
#define MA_QROW(i) (MODE ? R0 + 16 * (T0 + (i)) + r : R0 + Q0 + (i))
        const bf16* qp = PROJ + (size_t)MA_QROW(r32) * PW + h * 128 + hi * 8;
        bf16x8 qr[8];
#pragma unroll
        for (int d0 = 0; d0 < 8; ++d0) qr[d0] = *(const bf16x8*)(qp + d0 * 16);
        f32x16 o[4];
#pragma unroll
        for (int d = 0; d < 4; ++d)
#pragma unroll
            for (int i = 0; i < 16; ++i) o[d][i] = 0.f;
        float m_reg = -1e30f, l_reg = 0.f;
        if (MODE) {
            const float2 ml = *(const float2*)(PML + ((size_t)MA_QROW(r32) * 8 + h) * 2); m_reg = ml.x; l_reg = ml.y;
#pragma unroll
            for (int i = 0; i < 16; ++i) { const u32x2 w = *(const u32x2*)(PO + (size_t)MA_QROW(crow(i, hi)) * 1024 + h * 128 + r32 * 4);
                o[0][i] = bflo(w.x); o[1][i] = bfhi(w.x); o[2][i] = bflo(w.y); o[3][i] = bfhi(w.y); }
        }
        bf16x8 kf[8], vs[8];
        const bf16* vbase = PROJ + (size_t)R0 * PW + 2048 + h * 128 + vc;
#define MA_DESC(tix) const int br = MODE ? ((tix) >= 5) : 2, jj = MODE ? (tix) - (br ? 5 : 0) : (tix), sh = 4 - 2 * br, dd = 1 << sh, rd = r & (dd - 1), rq = r >> sh, \
        u0 = (MODE ? (T0 << (4 - sh)) + rq : Q0) - 64 + 32 * jj
#define MA_LOAD(tix) do { MA_DESC(tix); \
        _Pragma("unroll") for (int i8 = 0; i8 < 8; ++i8) { int pos = (u0 + 4 * i8 + vq) * dd + rd; pos = pos < 0 ? 0 : (pos > S - 1 ? S - 1 : pos); const bf16* vp = vbase + (size_t)pos * PW; \
            vs[i8] = *(const bf16x8*)vp; kf[i8] = *(const bf16x8*)(vp - 1024); } } while (0)
        MA_LOAD(0);
        for (int tix = 0; tix < NT; ++tix) {
            MA_DESC(tix);
#pragma unroll
            for (int i8 = 0; i8 < 8; ++i8) { *(LAS bf16x8*)(vbuf + vst_lane + ((i8 & 1) + 2 * (i8 >> 2)) * 2048 + ((i8 >> 1) & 1) * 256) = vs[i8];
                *(LAS bf16x8*)(kbuf + (4 * i8 + vq) * 256 + ((vc * 2) ^ (((4 * i8 + vq) & 7) << 4))) = kf[i8]; }
            f32x16 p;
#pragma unroll
            for (int i = 0; i < 16; ++i) p[i] = 0.f;
#pragma unroll
            for (int d0 = 0; d0 < 8; ++d0) { const bf16x8 ka = *(const LAS bf16x8*)(kbuf + r32 * 256 + (((d0 * 16 + hi * 8) * 2) ^ ((r32 & 7) << 4)));
                p = __builtin_amdgcn_mfma_f32_32x32x16_bf16(ka, qr[d0], p, 0, 0, 0); if (d0 == 3) SBAR(); }
            SBAR();
            const int Ld = S >> sh, ti = MODE ? ((T0 + r32) << (4 - sh)) + rq : Q0 + r32, base = u0 + 4 * hi - ti;
            const LAS float* tbh = tb + (br * 8 + h) * 132 + 65;
            const bool edge = (u0 < 0) || (u0 + 32 > Ld);
#pragma unroll
            for (int i = 0; i < 16; ++i) { int ru = base + (i & 3) + 8 * (i >> 2); ru = ru < -65 ? -65 : (ru > 65 ? 65 : ru); p[i] += tbh[ru]; }
            if (edge) {
#pragma unroll
                for (int i = 0; i < 16; ++i) { const int uu = u0 + 4 * hi + (i & 3) + 8 * (i >> 2); if (uu < 0 || uu >= Ld) p[i] = -__builtin_inff(); }
            }
            float pmax = p[0];
#pragma unroll
            for (int i = 1; i < 16; ++i) pmax = fmaxf(pmax, p[i]);
            pmax = half_max(pmax);
            float mn, alpha;
            if (__all(pmax - m_reg <= 8.f)) { mn = m_reg; alpha = 1.f; }
            else { mn = fmaxf(m_reg, pmax); alpha = __builtin_amdgcn_exp2f(m_reg - mn); m_reg = mn; }
            float ps = 0.f;
#pragma unroll
            for (int i = 0; i < 16; ++i) { p[i] = __builtin_amdgcn_exp2f(p[i] - mn); ps += p[i]; }
            ps = half_add(ps);
            l_reg = l_reg * alpha + ps;
            if (__any(alpha < 1.f)) { if (hi == 0) al_l[r32] = alpha; LDS_WAIT();
#pragma unroll
                for (int i = 0; i < 16; ++i) { const float a = al_l[crow(i, hi)];
#pragma unroll
                    for (int d = 0; d < 4; ++d) o[d][i] *= a; } }
            bf16x8 pa0, pa1; PK4(p, 0, pa0); PK4(p, 8, pa1);
            if (tix + 1 < NT) MA_LOAD(tix + 1);
            pv_one<0>(o[0], vb0, pa0, pa1); pv_one<1>(o[1], vb0, pa0, pa1); pv_one<2>(o[2], vb0, pa0, pa1); pv_one<3>(o[3], vb0, pa0, pa1);
        }
#undef MA_LOAD
#undef MA_DESC
        if (!MODE) {
            if (hi == 0) *(float2*)(PML + ((size_t)MA_QROW(r32) * 8 + h) * 2) = make_float2(m_reg, l_reg);
#pragma unroll
            for (int i = 0; i < 16; ++i) { u32x2 w; w.x = cvtpk(o[0][i], o[1][i]); w.y = cvtpk(o[2][i], o[3][i]);
                *(u32x2*)(PO + (size_t)MA_QROW(crow(i, hi)) * 1024 + h * 128 + r32 * 4) = w; }
            continue;
        }
        if (hi == 0) li_l[r32] = l_reg; LDS_WAIT();
        float sq[16];
#pragma unroll
        for (int i = 0; i < 16; ++i) { const float rl = __builtin_amdgcn_rcpf(li_l[crow(i, hi)]); float s = 0.f;
#pragma unroll
            for (int d = 0; d < 4; ++d) { o[d][i] *= rl; s += o[d][i] * o[d][i]; }
            sq[i] = s; }
#pragma unroll
        for (int off = 1; off < 32; off <<= 1)
#pragma unroll
            for (int i = 0; i < 16; ++i) sq[i] += __shfl_xor(sq[i], off);
        LAS float* sp = ssq + par * 256;
        if (r32 == 0) {
#pragma unroll
            for (int i = 0; i < 16; ++i) sp[h * 32 + crow(i, hi)] = sq[i]; }
        __syncthreads();
        float gv[4];
#pragma unroll
        for (int d = 0; d < 4; ++d) gv[d] = norm_a_g[h * 128 + 32 * d + r32];
#pragma unroll
        for (int i = 0; i < 16; ++i) { const int qi = crow(i, hi); float tot = 0.f;
#pragma unroll
            for (int hh = 0; hh < 8; ++hh) tot += sp[hh * 32 + qi];
            const float rs = 1.f / sqrtf(tot * (1.f / 1024.f) + EPS);
            bf16* op = MIXED + (size_t)MA_QROW(qi) * DM + h * 128 + r32;
#pragma unroll
            for (int d = 0; d < 4; ++d) op[32 * d] = (bf16)f2bf(o[d][i] * rs * gv[d]); }
    }
#undef MA_QROW
    __syncthreads();
}
}

namespace mixb {
constexpr int SHM_V = 16384, SHM_K = 16384, TB_OFF = 65536, WS_OFF = 98304;
#define KSWZ(row, colB) ((row) * 256 + ((colB) ^ (((row) & 7) << 4)))
__device__ __forceinline__ void partialSM(f32x16& p0, f32x16& p1, const LAS float* tbp, int relc, float cL, float cR, float& m_reg, float& mn, float& alpha) {
    float cb = 0.f;
    if (relc + 63 <= -559) cb = cL;
    else if (relc - 31 >= 559) cb = cR;
    else {
#pragma unroll
        for (int r = 0; r < 16; ++r) { p0[r] += tbp[(r & 3) + 8 * (r >> 2)]; p1[r] += tbp[32 + (r & 3) + 8 * (r >> 2)]; }
    }
    float pmax = p0[0];
#pragma unroll
    for (int r = 1; r < 16; ++r) pmax = fmaxf(pmax, p0[r]);
#pragma unroll
    for (int r = 0; r < 16; ++r) pmax = fmaxf(pmax, p1[r]);
    pmax = half_max(pmax) + cb;
    if (__builtin_expect(__all(pmax - m_reg <= 8.f), 1)) { mn = m_reg; alpha = 1.f; }
    else { mn = fmaxf(m_reg, pmax); alpha = __builtin_amdgcn_exp2f(m_reg - mn); m_reg = mn; }
    const float sh = mn - cb;
#pragma unroll
    for (int r = 0; r < 16; ++r) { p0[r] -= sh; p1[r] -= sh; }
#pragma unroll
    for (int r = 0; r < 16; ++r) p0[r] = __builtin_amdgcn_exp2f(p0[r]);
}
__device__ __forceinline__ void finishSM(f32x16& p0, f32x16& p1, float alpha, float& l_reg, bf16x8& pa0, bf16x8& pa1, bf16x8& pa2, bf16x8& pa3) {
#pragma unroll
    for (int r = 0; r < 16; ++r) p1[r] = __builtin_amdgcn_exp2f(p1[r]);
    float ps = 0;
#pragma unroll
    for (int r = 0; r < 16; ++r) ps += p0[r];
#pragma unroll
    for (int r = 0; r < 16; ++r) ps += p1[r];
    ps = half_add(ps);
    l_reg = l_reg * alpha + ps;
    PK4(p0, 0, pa0); PK4(p0, 8, pa1); PK4(p1, 0, pa2); PK4(p1, 8, pa3);
}
__device__ __forceinline__ void qkt(f32x16& p0, f32x16& p1, const LAS unsigned char* Ks, const bf16x8* qr, int r32, int cb0) {
#pragma unroll
    for (int i = 0; i < 16; ++i) { p0[i] = 0.f; p1[i] = 0.f; }
#pragma unroll
    for (int d0 = 0; d0 < 4; ++d0) { const int cb = cb0 + d0 * 32;
        const bf16x8 b0 = *(const LAS bf16x8*)(Ks + KSWZ(r32, cb));
        const bf16x8 b1 = *(const LAS bf16x8*)(Ks + KSWZ(32 + r32, cb));
        p0 = __builtin_amdgcn_mfma_f32_32x32x16_bf16(b0, qr[d0], p0, 0, 0, 0);
        p1 = __builtin_amdgcn_mfma_f32_32x32x16_bf16(b1, qr[d0], p1, 0, 0, 0); }
}
template <int D0> __device__ __forceinline__ void pv_one(f32x16& od, int vb, bf16x8 pa0, bf16x8 pa1, bf16x8 pa2, bf16x8 pa3) {
    s16x4 l0 = tr_read<v_rd_off(D0, 0, 0)>(vb), h0 = tr_read<v_rd_off(D0, 0, 1)>(vb), l1 = tr_read<v_rd_off(D0, 1, 0)>(vb), h1 = tr_read<v_rd_off(D0, 1, 1)>(vb);
    s16x4 l2 = tr_read<v_rd_off(D0, 2, 0)>(vb), h2 = tr_read<v_rd_off(D0, 2, 1)>(vb), l3 = tr_read<v_rd_off(D0, 3, 0)>(vb), h3 = tr_read<v_rd_off(D0, 3, 1)>(vb);
    asm volatile("s_waitcnt lgkmcnt(0)" : "+v"(l0), "+v"(h0), "+v"(l1), "+v"(h1), "+v"(l2), "+v"(h2), "+v"(l3), "+v"(h3) :: "memory");
    od = __builtin_amdgcn_mfma_f32_32x32x16_bf16(pa0, PKV(l0, h0), od, 0, 0, 0);
    od = __builtin_amdgcn_mfma_f32_32x32x16_bf16(pa1, PKV(l1, h1), od, 0, 0, 0);
    od = __builtin_amdgcn_mfma_f32_32x32x16_bf16(pa2, PKV(l2, h2), od, 0, 0, 0);
    od = __builtin_amdgcn_mfma_f32_32x32x16_bf16(pa3, PKV(l3, h3), od, 0, 0, 0);
}
__device__ __forceinline__ void pv_d0(f32x16* o, int vb, bf16x8 pa0, bf16x8 pa1, bf16x8 pa2, bf16x8 pa3) {
    pv_one<0>(o[0], vb, pa0, pa1, pa2, pa3); pv_one<1>(o[1], vb, pa0, pa1, pa2, pa3); pv_one<2>(o[2], vb, pa0, pa1, pa2, pa3); pv_one<3>(o[3], vb, pa0, pa1, pa2, pa3);
}
__device__ __forceinline__ void unit(LAS unsigned char* lds, const bf16* __restrict__ PROJ, bf16* __restrict__ MIXED, const float* __restrict__ subln_g, float lam, int R0, int seq, int h, int qb) {
    const int tid = threadIdx.x, wid = __builtin_amdgcn_readfirstlane(tid >> 6), lane = tid & 63, r32 = lane & 31, hi = lane >> 5;
    const int g = wid >> 1, c = wid & 1;
    LAS unsigned char* V_lds = lds; LAS unsigned char* K_lds = lds + 2 * SHM_V;
    const LAS float* tb = (const LAS float*)(lds + TB_OFF);
    LAS float* ws = (LAS float*)(lds + WS_OFF) + wid * 64; LAS float* li_l = ws; LAS float* al_l = ws + 32;
    float m_reg = -1e30f, l_reg = 0.f; f32x16 o[4]; bf16x8 qr[4];
#pragma unroll
    for (int d = 0; d < 4; ++d)
#pragma unroll
        for (int i = 0; i < 16; ++i) o[d][i] = 0.f;
    const int qrow = 128 * qb + 32 * g + r32;
    const bf16* Qw = PROJ + (size_t)(R0 + qrow) * PW + 3072 + h * 128 + c * 64 + hi * 8;
#pragma unroll
    for (int d0 = 0; d0 < 4; ++d0) qr[d0] = *(const bf16x8*)(Qw + d0 * 16);
    const bf16* Kh = PROJ + (size_t)R0 * PW + 4096 + h * 128; const bf16* Vh = PROJ + (size_t)R0 * PW + 5120 + h * 128;
    const int sr = tid >> 4, sc = (tid & 15) * 8, vst0 = v_st(sr, sc), vst1 = v_st(32 + sr, sc);
    const int vb0 = (int)(uintptr_t)V_lds + v_rd_base(lane);
    const int cb0 = (c * 64 + hi * 8) * 2;
    const LAS float* tbq = tb + (4095 - qrow + 4 * hi);
    const int rc0 = -(128 * qb + 32 * g);
    const float cL = tb[0], cR = tb[8190];
    struct { bf16x8 vs0, vs1, ks0, ks1; } sr_[2];
#define SLOAD(i, k0) do { sr_[i].vs0 = *(const bf16x8*)(Vh + (size_t)((k0) + sr) * PW + sc); sr_[i].vs1 = *(const bf16x8*)(Vh + (size_t)((k0) + 32 + sr) * PW + sc); \
    sr_[i].ks0 = *(const bf16x8*)(Kh + (size_t)((k0) + sr) * PW + sc); sr_[i].ks1 = *(const bf16x8*)(Kh + (size_t)((k0) + 32 + sr) * PW + sc); } while (0)
#define SWRITE(b, i) do { *(LAS bf16x8*)(V_lds + (b) * SHM_V + vst0) = sr_[i].vs0; *(LAS bf16x8*)(V_lds + (b) * SHM_V + vst1) = sr_[i].vs1; const int kc = sc * 2; \
    *(LAS bf16x8*)(K_lds + (b) * SHM_K + KSWZ(sr, kc)) = sr_[i].ks0; *(LAS bf16x8*)(K_lds + (b) * SHM_K + KSWZ(32 + sr, kc)) = sr_[i].ks1; } while (0)
#define SWAIT() asm volatile("s_waitcnt vmcnt(4)" ::: "memory")
#define RESC(a) do { if (__any((a) < 1.f)) { if (hi == 0) al_l[r32] = (a); LDS_WAIT(); \
    _Pragma("unroll") for (int r = 0; r < 16; ++r) { const float av = al_l[crow(r, hi)]; _Pragma("unroll") for (int d = 0; d < 4; ++d) o[d][r] *= av; } } } while (0)
    f32x16 pA0, pA1, pB0, pB1; float mnA, mnB, alA, alB; bf16x8 pa0, pa1, pa2, pa3; const int NT = seq / 64;
    constexpr int SE = 0, SO = 1;
    SLOAD(SE, 0); asm volatile("s_waitcnt vmcnt(0)" ::: "memory"); SWRITE(0, SE); __syncthreads();
    qkt(pA0, pA1, K_lds, qr, r32, cb0); partialSM(pA0, pA1, tbq, rc0, cL, cR, m_reg, mnA, alA);
    SLOAD(SO, 64); if (2 < NT) SLOAD(SE, 128);
    SWAIT(); SWRITE(1, SO); __syncthreads();
    for (int j = 1; j + 1 < NT; j += 2) {
        SBAR(); qkt(pB0, pB1, K_lds + SHM_K, qr, r32, cb0);
        finishSM(pA0, pA1, alA, l_reg, pa0, pa1, pa2, pa3); SBAR();
        SLOAD(SO, (j + 2) * 64); SBAR();
        pv_d0(o, vb0, pa0, pa1, pa2, pa3); partialSM(pB0, pB1, tbq + j * 64, rc0 + j * 64, cL, cR, m_reg, mnB, alB);
        __syncthreads(); SWAIT(); SWRITE(0, SE);
        RESC(alB); __syncthreads();
        SBAR(); qkt(pA0, pA1, K_lds, qr, r32, cb0);
        finishSM(pB0, pB1, alB, l_reg, pa0, pa1, pa2, pa3); SBAR();
        if (j + 3 < NT) SLOAD(SE, (j + 3) * 64); SBAR();
        pv_d0(o, vb0 + SHM_V, pa0, pa1, pa2, pa3); partialSM(pA0, pA1, tbq + (j + 1) * 64, rc0 + (j + 1) * 64, cL, cR, m_reg, mnA, alA);
        __syncthreads(); SWAIT(); SWRITE(1, SO);
        RESC(alA); __syncthreads();
    }
    SBAR(); qkt(pB0, pB1, K_lds + SHM_K, qr, r32, cb0);
    finishSM(pA0, pA1, alA, l_reg, pa0, pa1, pa2, pa3); SBAR();
    pv_d0(o, vb0, pa0, pa1, pa2, pa3); partialSM(pB0, pB1, tbq + (NT - 1) * 64, rc0 + (NT - 1) * 64, cL, cR, m_reg, mnB, alB);
    __syncthreads(); RESC(alB);
    finishSM(pB0, pB1, alB, l_reg, pa0, pa1, pa2, pa3); SBAR();
    pv_d0(o, vb0 + SHM_V, pa0, pa1, pa2, pa3);
#undef SLOAD
#undef SWRITE
#undef SWAIT
#undef RESC
    if (hi == 0) li_l[r32] = l_reg; LDS_WAIT();
    float rli[16];
#pragma unroll
    for (int r = 0; r < 16; ++r) rli[r] = __builtin_amdgcn_rcpf(li_l[crow(r, hi)]);
    __syncthreads();
    LAS float* xch = (LAS float*)lds + g * 4096;
    if (c == 1) {
#pragma unroll
        for (int d = 0; d < 4; ++d)
#pragma unroll
            for (int r = 0; r < 16; ++r) xch[(d * 16 + r) * 64 + lane] = o[d][r] * rli[r]; }
    __syncthreads();
    if (c == 0) {
        float sq[16];
#pragma unroll
        for (int r = 0; r < 16; ++r) { float s = 0.f;
#pragma unroll
            for (int d = 0; d < 4; ++d) { const float a = o[d][r] * rli[r] - lam * xch[(d * 16 + r) * 64 + lane]; o[d][r] = a; s += a * a; }
            sq[r] = s; }
#pragma unroll
        for (int off = 1; off < 32; off <<= 1)
#pragma unroll
            for (int r = 0; r < 16; ++r) sq[r] += __shfl_xor(sq[r], off);
        float gv[4];
#pragma unroll
        for (int d = 0; d < 4; ++d) gv[d] = subln_g[32 * d + r32] * 0.8f;
#pragma unroll
        for (int r = 0; r < 16; ++r) { const float rs = 1.f / sqrtf(sq[r] * (1.f / 128.f) + EPS);
            bf16* op = MIXED + (size_t)(R0 + 128 * qb + 32 * g + crow(r, hi)) * DM + 1024 + h * 128 + r32;
#pragma unroll
            for (int d = 0; d < 4; ++d) op[32 * d] = (bf16)f2bf(o[d][r] * rs * gv[d]); }
    }
    __syncthreads();
}
__device__ __forceinline__ void phase(LAS unsigned char* lds, const bf16* __restrict__ PROJ, bf16* __restrict__ MIXED, const float* __restrict__ tbB_g, const float* __restrict__ subln_g, float lam, int G, int vcu) {
    const int tid = threadIdx.x;
    for (int n = vcu; n < 4096; n += G) {
        const int i = n >> 8, v = n & 255, x = v >> 5, loc = v & 31;
        int R0, seq, h, qb;
        if (i < 8) { const int bh = 8 * i + x; R0 = (bh >> 3) * S_P; seq = S_P; h = bh & 7; qb = loc; }
        else { const int bh = 16 * (i - 8) + 2 * x + (loc >> 4); R0 = M_P + (bh >> 3) * S_S; seq = S_S; h = bh & 7; qb = loc & 15; }
        LAS f32x4* tb4 = (LAS f32x4*)(lds + TB_OFF); const f32x4* src = (const f32x4*)(tbB_g + h * 8192);
        for (int k = tid; k < 2048; k += 512) tb4[k] = src[k];
        __syncthreads();
        unit(lds, PROJ, MIXED, subln_g, lam, R0, seq, h, qb);
    }
}
}

__device__ __forceinline__ void p4_row(const float* xrow, const bf16* yrow, const float* g1, const float* g2, float* orow, bf16* hrow, int lane) {
    f32x4 v[8]; float s = 0.f;
#pragma unroll
    for (int j = 0; j < 8; ++j) { const u32x2 w = ((const u32x2*)yrow)[lane + 64 * j]; v[j] = (f32x4){bflo(w.x), bfhi(w.x), bflo(w.y), bfhi(w.y)}; s += (v[j].x * v[j].x + v[j].y * v[j].y) + (v[j].z * v[j].z + v[j].w * v[j].w); }
    const float r1 = 1.f / sqrtf(wave_sum(s) * (1.f / DM) + EPS); float s2 = 0.f;
#pragma unroll
    for (int j = 0; j < 8; ++j) { const f32x4 xv = ((const f32x4*)xrow)[lane + 64 * j], gv = ((const f32x4*)g1)[lane + 64 * j];
        v[j] = xv + v[j] * r1 * gv; ((f32x4*)orow)[lane + 64 * j] = v[j]; s2 += (v[j].x * v[j].x + v[j].y * v[j].y) + (v[j].z * v[j].z + v[j].w * v[j].w); }
    const float r2 = 1.f / sqrtf(wave_sum(s2) * (1.f / DM) + EPS);
#pragma unroll
    for (int j = 0; j < 8; ++j) { const f32x4 gv = ((const f32x4*)g2)[lane + 64 * j]; u32x2 w; w.x = cvtpk(v[j].x * r2 * gv.x, v[j].y * r2 * gv.y); w.y = cvtpk(v[j].z * r2 * gv.z, v[j].w * r2 * gv.w); ((u32x2*)hrow)[lane + 64 * j] = w; }
}
__device__ __forceinline__ void p7_row(const bf16* frow, const float* g, float* orow, int lane) {
    f32x4 v[8]; float s = 0.f;
#pragma unroll
    for (int j = 0; j < 8; ++j) { const u32x2 w = ((const u32x2*)frow)[lane + 64 * j]; v[j] = (f32x4){bflo(w.x), bfhi(w.x), bflo(w.y), bfhi(w.y)}; s += (v[j].x * v[j].x + v[j].y * v[j].y) + (v[j].z * v[j].z + v[j].w * v[j].w); }
    const float r1 = 1.f / sqrtf(wave_sum(s) * (1.f / DM) + EPS);
#pragma unroll
    for (int j = 0; j < 8; ++j) { const f32x4 xv = ((const f32x4*)orow)[lane + 64 * j], gv = ((const f32x4*)g)[lane + 64 * j]; ((f32x4*)orow)[lane + 64 * j] = xv + v[j] * r1 * gv; }
}

#define XB_TMO      128
#define XB_XCNT(j)  (256  + 64 * (j))
#define XB_XSUB(j)  (1280 + 64 * (j))
#define XB_XGEN(j)  (2304 + 64 * (j))
#define XB_TOP      3328
#define XB_TOPGEN   3392
#define XCD_BAR_WORDS 3456
#define XB_SPIN_CAP (1u << 18)

__device__ __forceinline__ unsigned xb_ld(unsigned* p)              { return __hip_atomic_load(p, __ATOMIC_RELAXED, __HIP_MEMORY_SCOPE_AGENT); }
__device__ __forceinline__ unsigned xb_add(unsigned* p, unsigned v) { return __hip_atomic_fetch_add(p, v, __ATOMIC_RELAXED, __HIP_MEMORY_SCOPE_AGENT); }
__device__ __forceinline__ unsigned xb_xcc_id() { return (unsigned)__builtin_amdgcn_s_getreg((3 << 11) | 20) & 0xFu; }
#define XB_SPIN(cond, bar) do { unsigned _sp = 0; while (cond) { __builtin_amdgcn_s_sleep(1); \
    if ((++_sp & 255u) == 0u) { if (xb_ld(&(bar)[XB_TMO])) break; if (_sp > XB_SPIN_CAP) { atomicAdd(&(bar)[XB_TMO], 1u); break; } } } } while (0)

struct XcdBarrier {
    unsigned* bar; unsigned x;
    volatile LAS unsigned* st;
};

__device__ __forceinline__ XcdBarrier xcd_barrier_post(unsigned* bar, volatile LAS unsigned* st) {
    XcdBarrier b; b.bar = bar; b.x = xb_xcc_id(); b.st = st;
    if (threadIdx.x == 0) (void)xb_add(&bar[XB_XCNT(b.x)], 1u);
    return b;
}
__device__ __forceinline__ void xcd_barrier_complete(unsigned* bar, unsigned x, unsigned& nloc, unsigned& nx) {
    const unsigned G = gridDim.x * gridDim.y * gridDim.z;
    unsigned sum, cnt, mine, sp = 0u;
    for (;;) {
        sum = 0u; cnt = 0u; mine = 0u;
#pragma unroll
        for (unsigned j = 0; j < 16; ++j) { const unsigned c = xb_ld(&bar[XB_XCNT(j)]); sum += c; cnt += (c > 0u) ? 1u : 0u; mine = (j == x) ? c : mine; }
        if (sum == G) break;
        __builtin_amdgcn_s_sleep(1);
        if ((++sp & 255u) == 0u) { if (xb_ld(&bar[XB_TMO])) break; if (sp > XB_SPIN_CAP) { atomicAdd(&bar[XB_TMO], 1u); break; } }
    }
    nloc = mine > 0u ? mine : 1u; nx = cnt > 0u ? cnt : 1u;
}

__device__ __forceinline__ void xcd_barrier(const XcdBarrier& b) {
    asm volatile("s_waitcnt vmcnt(0)" ::: "memory");
    __syncthreads();
    if (threadIdx.x == 0) {
        unsigned* bar = b.bar;
        __builtin_amdgcn_s_waitcnt(0);
        unsigned nloc = b.st[0], nx = b.st[1];
        if (nloc == 0u) { xcd_barrier_complete(bar, b.x, nloc, nx); b.st[0] = nloc; b.st[1] = nx; }
        const unsigned old = xb_add(&bar[XB_XSUB(b.x)], 1u);
        const unsigned gen = old / nloc;
        if (old + 1u == (gen + 1u) * nloc) {
            __builtin_amdgcn_fence(__ATOMIC_RELEASE, "agent");
            asm volatile("s_waitcnt vmcnt(0)" ::: "memory");
            const unsigned og = xb_add(&bar[XB_TOP], 1u);
            const unsigned tg = og / nx;
            if (og + 1u == (tg + 1u) * nx) xb_add(&bar[XB_TOPGEN], 1u);
            else XB_SPIN(xb_ld(&bar[XB_TOPGEN]) == tg, bar);
            __builtin_amdgcn_fence(__ATOMIC_ACQUIRE, "agent");
            xb_add(&bar[XB_XGEN(b.x)], 1u);
            asm volatile("s_waitcnt vmcnt(0)" ::: "memory");
        } else {
            XB_SPIN(xb_ld(&bar[XB_XGEN(b.x)]) == gen, bar);
            __builtin_amdgcn_fence(__ATOMIC_ACQUIRE, "agent");
            asm volatile("s_waitcnt vmcnt(0)" ::: "memory");
        }
    }
    __syncthreads();
}

struct Args { const float* in[18]; float* out; unsigned char* ws; int ph_lo, ph_hi; };
constexpr int N_PHASES = 8;
__global__ void __launch_bounds__(512, 2) fwd_mega(Args a) {
    extern __shared__ __attribute__((aligned(16))) unsigned char lds_raw[];
    LAS unsigned char* lds = (LAS unsigned char*)lds_raw;
    cg::grid_group grid = cg::this_grid();
    const int tid = threadIdx.x, lane = tid & 63, wave = __builtin_amdgcn_readfirstlane(tid >> 6);
    const int G = gridDim.x, bx = blockIdx.x;
    const int vcu = (G % 8 == 0) ? (bx % 8) * (G / 8) + bx / 8 : bx;
    const int lo = a.ph_lo, hi = a.ph_hi;
    unsigned char* ws = a.ws;
    bf16* WIN = (bf16*)(ws + WS_WIN); bf16* WOUT = (bf16*)(ws + WS_WOUT); bf16* WGU = (bf16*)(ws + WS_WGU); bf16* WDN = (bf16*)(ws + WS_WDN);
    float* TBB = (float*)(ws + WS_TBB); float* TBA = (float*)(ws + WS_TBA); float* SS = (float*)(ws + WS_SS);
    unsigned* PCNT = (unsigned*)(ws + WS_CTL + 16384);
    bf16* H = (bf16*)(ws + WS_H); bf16* PROJ = (bf16*)(ws + WS_PROJ); bf16* F = PROJ; bf16* MIXED = (bf16*)(ws + WS_MIXED); bf16* Y = (bf16*)(ws + WS_Y);
    const int gw = vcu * 8 + wave, NGW = G * 8;
#ifndef PH_MASK
#define PH_MASK 0x3ff
#endif
#define IN(k) (((PH_MASK >> (k)) & 1) && lo <= (k) && (k) < hi)
#define SEAM(k) do { if (IN(k) && IN((k) + 1)) xcd_barrier(bar); } while (0)
    XcdBarrier bar; bar.bar = (unsigned*)(ws + WS_CTL); bar.x = 0; bar.st = (volatile LAS unsigned*)(lds + BAR_LDS_OFF);
    if (hi - lo > 1) {
        if (tid < 2) ((volatile LAS unsigned*)(lds + BAR_LDS_OFF))[tid] = 0u;
        __syncthreads();
        bar = xcd_barrier_post((unsigned*)(ws + WS_CTL), (volatile LAS unsigned*)(lds + BAR_LDS_OFF));
    }
    if (hi > 1000) grid.sync();

    for (int p0rep = 0; p0rep < ((PROBE_DUP & 8) ? 2 : 1); ++p0rep)
    if (IN(0)) {
        LAS float* scr = (LAS float*)(lds + wave * 16384);
        constexpr int I_IN = (DM / 64) * (PW / 32), I_OUT = (DM / 64) * (DM / 32), I_G = (DM / 64) * (DFF / 32), I_D = (DFF / 64) * (DM / 32);
        constexpr int NITEMS = I_IN + I_OUT + 2 * I_G + I_D;
        for (int it = gw; it < NITEMS; it += NGW) {
            int r = it;
            if (r < I_IN) { p0_transpose_item(a.in[6], DM, PW, WIN, 0, scr, r, lane); continue; } r -= I_IN;
            if (r < I_OUT) { p0_transpose_item(a.in[7], DM, DM, WOUT, 0, scr, r, lane); continue; } r -= I_OUT;
            if (r < I_G) { p0_transpose_item(a.in[14], DM, DFF, WGU, 1, scr, r, lane); continue; } r -= I_G;
            if (r < I_G) { p0_transpose_item(a.in[15], DM, DFF, WGU, 2, scr, r, lane); continue; } r -= I_G;
            p0_transpose_item(a.in[16], DFF, DM, WDN, 0, scr, r, lane);
        }
        const float* rb = a.in[17];
        for (int idx = bx * 512 + tid; idx < 8 * 8192; idx += G * 512) { const int hh = idx >> 13, rel = (idx & 8191) - 4095; TBB[idx] = rb[rel_bucket(rel) * 16 + 8 + hh] * LOG2E; }
        for (int idx = bx * 512 + tid; idx < 3 * 8 * 132; idx += G * 512) { const int br = idx / (8 * 132), hh = (idx / 132) % 8, j = idx % 132, d = 16 >> (2 * br);
            TBA[idx] = (j == 0 || j >= 130) ? -__builtin_inff() : rb[rel_bucket(d * (j - 65)) * 16 + hh] * LOG2E; }
        for (int idx = bx * 512 + tid; idx < 3 * MT; idx += G * 512) SS[idx] = 0.f;
        for (int m = gw; m < MT; m += NGW) prenorm_row(xrow_ptr(a.in[0], a.in[1], m), a.in[2], H + (size_t)m * DM, lane);
    }
    SEAM(0);
    if (IN(1)) {
        pg8::Gemm g{H, WIN, MT, PW, DM}; pg8::StaticOrder S; S.init(MT, PW, G, bx);
        pg8::EpiBf16S E{PROJ, PW, Q_SCALE_A, Q_SCALE_B};
        pg8::gemm_phase<pg8::EpiBf16S, pg8::StaticOrder, true, true>(lds, g, S, E);
    }
    SEAM(1);
    if (IN(2)) {
        bf16* PO = Y; float* PML = (float*)(ws + WS_Y + 128 * MiB);
        mixa::phase<0>(lds, PROJ, MIXED, TBA, a.in[8], PO, PML, G, vcu);
        if (PH_MASK & 0x200) {
            const float s1 = a.in[9][lane] * a.in[10][lane], s2 = a.in[11][lane] * a.in[12][lane];
            const float lam = __expf(wave_sum(s1)) - __expf(wave_sum(s2)) + 0.2f;
            mixb::phase(lds, PROJ, MIXED, TBB, a.in[13], lam, G, vcu);
        }
        if (hi - lo > 1) xcd_barrier(bar);
        mixa::phase<1>(lds, PROJ, MIXED, TBA, a.in[8], PO, PML, G, vcu);
    }
    SEAM(2);
    if (IN(3)) {
        pg8::Gemm g{MIXED, WOUT, MT, DM, DM};
#if FUSED_NORM
        if (G == 256) {
            pg8::PanelOrder S{bx, 8};
            pg8::EpiNormResNorm E{a.in[0], a.in[1], Y, H, a.in[3], a.in[4], SS, SS + MT, PCNT, PCNT + 256 * 64};
            pg8::gemm_phase<pg8::EpiNormResNorm, pg8::PanelOrder, true, true>(lds, g, S, E);
        }
#else
        pg8::StaticOrder S; S.init(MT, DM, G, bx);
        pg8::EpiBf16S E{Y, DM, 1.f, 1.f};
        pg8::gemm_phase<pg8::EpiBf16S, pg8::StaticOrder, true, true>(lds, g, S, E);
#endif
    }
    SEAM(3);
    if (IN(4) && !FUSED_NORM) {
        for (int m = gw; m < MT; m += NGW) p4_row(xrow_ptr(a.in[0], a.in[1], m), Y + (size_t)m * DM, a.in[3], a.in[4], a.out + (size_t)m * DM, H + (size_t)m * DM, lane);
    }
    if (!FUSED_NORM) SEAM(4);
    if (IN(5)) {
        pg8::Gemm g{H, WGU, MT, 2 * DFF, DM}; pg8::StaticOrder S; S.init(MT, 2 * DFF, G, bx);
        pg8::EpiSwiGLU E{F, DFF};
        pg8::gemm_phase<pg8::EpiSwiGLU, pg8::StaticOrder, true, true>(lds, g, S, E);
#if PROBE_DUP & 4
        pg8::gemm_phase<pg8::EpiSwiGLU, pg8::StaticOrder, true, true>(lds, g, S, E);
#endif
    }
    SEAM(5);
    if (IN(6)) {
        pg8::Gemm g{F, WDN, MT, DM, DFF};
#if FUSED_NORM
        if (G == 256) {
            pg8::PanelOrder S{bx, 8};
            pg8::EpiNormResOut E{a.out, Y, a.in[5], SS + 2 * MT, PCNT + 512 * 64};
            pg8::gemm_phase<pg8::EpiNormResOut, pg8::PanelOrder, true, true>(lds, g, S, E);
        }
#else
        pg8::StaticOrder S; S.init(MT, DM, G, bx);
        pg8::EpiBf16S E{Y, DM, 1.f, 1.f};
        pg8::gemm_phase<pg8::EpiBf16S, pg8::StaticOrder, true, true>(lds, g, S, E);
#endif
    }
    if (!FUSED_NORM) SEAM(6);
    if (IN(7) && !FUSED_NORM) {
        for (int m = gw; m < MT; m += NGW) p7_row(Y + (size_t)m * DM, a.in[5], a.out + (size_t)m * DM, lane);
    }
#undef IN
#undef SEAM
}

#ifndef MK_ONE_LAUNCH
#define MK_ONE_LAUNCH 1
#endif
extern "C" void kernel_launch(void* const* d_in, const int* in_sizes, int n_in, void* d_out, int out_size, void* d_ws, size_t ws_size, hipStream_t stream) {
    static int grid = 0;
    if (grid == 0) {
        if (n_in != 18 || out_size != MT * DM || ws_size < WS_END) { fprintf(stderr, "kernel_launch: unexpected shapes (n_in %d, out %d, ws %zu)\n", n_in, out_size, ws_size); grid = -1; return; }
        int dev = 0, cus = 0, per_cu = 0;
        if (hipGetDevice(&dev) != hipSuccess || hipDeviceGetAttribute(&cus, hipDeviceAttributeMultiprocessorCount, dev) != hipSuccess) { grid = -1; return; }
        if (hipFuncSetAttribute((const void*)fwd_mega, hipFuncAttributeMaxDynamicSharedMemorySize, LDS_BYTES) != hipSuccess) { fprintf(stderr, "kernel_launch: hipFuncSetAttribute failed\n"); grid = -1; return; }
        if (hipOccupancyMaxActiveBlocksPerMultiprocessor(&per_cu, (const void*)fwd_mega, 512, LDS_BYTES) != hipSuccess || per_cu < 1) { fprintf(stderr, "kernel_launch: occupancy query says %d blocks per CU\n", per_cu); per_cu = 1; }
        (void)hipGetLastError();
        grid = cus * 1;
    }
    if (grid < 0) return;
    if (hipMemsetAsync((char*)d_ws + WS_CTL, 0, 262144, stream) != hipSuccess) { fprintf(stderr, "kernel_launch: memset of the barrier words failed\n"); return; }
    Args a{};
    for (int i = 0; i < 18; ++i) a.in[i] = (const float*)d_in[i];
    a.out = (float*)d_out; a.ws = (unsigned char*)d_ws;
#if MK_ONE_LAUNCH
    a.ph_lo = 0; a.ph_hi = N_PHASES;
    void* args[] = {&a};
    hipError_t e = hipLaunchCooperativeKernel((const void*)fwd_mega, dim3(grid), dim3(512), args, LDS_BYTES, stream);
    if (e != hipSuccess) fprintf(stderr, "kernel_launch: cooperative launch failed: %s (grid %d)\n", hipGetErrorString(e), grid);
#else
    for (int p = 0; p < N_PHASES; ++p) { a.ph_lo = p; a.ph_hi = p + 1; hipLaunchKernelGGL(fwd_mega, dim3(grid), dim3(512), LDS_BYTES, stream, a); }
#endif
}
```
